# Optimizing an MI355X kernel written in HIP

```python
import math
import jax, jax.numpy as jnp
from jax import lax
import numpy as np

D_MODEL = 1024
BATCH = 32
SEQ = 256
DEPTH = 4
DEC_BATCH = 4
DEC_SEQ = 1024
PAST_LEN = 256

GRID_W = 64
N_BRANCH = 4
BRANCH_WIDTH = 512
FFT_GROUPS = 4
FFT_GROUP_CH = 128
FFT_WIDTH = FFT_GROUPS * FFT_GROUP_CH
CONV_WIDTH = 512
CONV_K = 3
SSM_GROUPS = 32
SSM_CH = 16
SSM_WIDTH = SSM_GROUPS * SSM_CH
SSM_STATE = 64
N_HEADS = 8
N_KV = 2
Q_PER_KV = N_HEADS // N_KV
HEAD_DIM = 64
ATT_WIDTH = N_HEADS * HEAD_DIM
WINDOW = 128
ATT_BLOCK = 128
ROPE_BASE = 10000.0
IN_SIZES = (FFT_WIDTH, CONV_WIDTH, CONV_WIDTH, CONV_WIDTH, SSM_WIDTH, ATT_WIDTH,
            N_KV * HEAD_DIM, N_KV * HEAD_DIM, N_BRANCH * D_MODEL)
IN_COLS = sum(IN_SIZES)
PEER_HEADS = 8
N_KEYS = 128
N_EXPERTS = N_KEYS * N_KEYS
PEER_TOPK = 16
KEY_DIM = 256
PEER_CHUNK = 128
LN_EPS = 1e-5
DEEPNORM_ALPHA = (2 * DEPTH) ** 0.25
DEEPNORM_BETA = (8 * DEPTH) ** -0.25
NEG_INF = -1e30

kernel_name = "hybrid_diffusion_prefix_step"


def layer_norm(x, g, b):
    xf = x.astype(jnp.float32)
    mu = jnp.mean(xf, axis=-1, keepdims=True)
    var = jnp.mean(jnp.square(xf - mu), axis=-1, keepdims=True)
    y = (xf - mu) * lax.rsqrt(var + LN_EPS) * g.astype(jnp.float32) + b.astype(jnp.float32)
    return y.astype(x.dtype)


def modulation(cvec, w_ada, b_ada):
    mod = (jax.nn.silu(cvec) @ w_ada + b_ada)[:, None, :]
    return jnp.split(mod, 6, axis=-1)


def axial_rope(length):
    t = jnp.arange(length)
    row = (t // GRID_W).astype(jnp.float32)
    col = (t % GRID_W).astype(jnp.float32)
    n_freq = HEAD_DIM // 4
    inv = 1.0 / (ROPE_BASE ** (jnp.arange(n_freq, dtype=jnp.float32) / n_freq))
    ang = jnp.stack([row[:, None] * inv, col[:, None] * inv], axis=1)
    return jnp.cos(ang), jnp.sin(ang)


def apply_rope(x, cos, sin):
    xr = x.astype(jnp.float32).reshape(x.shape[:-1] + (2, 2, HEAD_DIM // 4))
    extra = x.ndim - 3
    c = cos.reshape((cos.shape[0],) + (1,) * extra + cos.shape[1:])
    s = sin.reshape((sin.shape[0],) + (1,) * extra + sin.shape[1:])
    x1, x2 = xr[..., 0, :], xr[..., 1, :]
    out = jnp.stack([x1 * c - x2 * s, x2 * c + x1 * s], axis=-2)
    return out.reshape(x.shape).astype(x.dtype)


def context_attention(q, k, v, sink):
    b, s_len = q.shape[:2]
    nq = s_len // ATT_BLOCK
    scale = HEAD_DIM ** -0.5
    qb = jnp.moveaxis(q.reshape(b, nq, ATT_BLOCK, N_KV, Q_PER_KV, HEAD_DIM), 1, 0)
    kf, vf = k.astype(jnp.float32), v.astype(jnp.float32)
    sink_b = sink.astype(jnp.float32).reshape(N_KV, Q_PER_KV)[None, :, :, None, None]

    def one_block(qblk):
        sc = jnp.einsum('bqhrd,bkhd->bhrqk', qblk.astype(jnp.float32), kf) * scale
        snk = jnp.broadcast_to(sink_b, sc.shape[:-1] + (1,))
        p = jax.nn.softmax(jnp.concatenate([sc, snk], axis=-1), axis=-1)[..., :s_len]
        return jnp.einsum('bhrqk,bkhd->bqhrd', p, vf)

    out = lax.map(one_block, qb)
    return jnp.moveaxis(out, 0, 1).reshape(b, s_len, ATT_WIDTH).astype(q.dtype)


def latent_attention(q, k, v, kc, vc, sink):
    b, length = q.shape[:2]
    nb = length // ATT_BLOCK
    lc = kc.shape[1]
    nw = 3 * ATT_BLOCK
    scale = HEAD_DIM ** -0.5
    qb = q.reshape(b, nb, ATT_BLOCK, N_KV, Q_PER_KV, HEAD_DIM).astype(jnp.float32)

    def windows(t):
        tp = jnp.pad(t, ((0, 0), (ATT_BLOCK, ATT_BLOCK), (0, 0), (0, 0)))
        tp = tp.reshape(b, nb + 2, ATT_BLOCK, N_KV, HEAD_DIM)
        return jnp.concatenate([tp[:, :nb], tp[:, 1:nb + 1], tp[:, 2:]], axis=2).astype(jnp.float32)

    kw, vw = windows(k), windows(v)
    qpos = jnp.arange(length).reshape(nb, ATT_BLOCK)
    kpos = (jnp.arange(nb)[:, None] - 1) * ATT_BLOCK + jnp.arange(nw)[None, :]
    valid = ((jnp.abs(qpos[:, :, None] - kpos[:, None, :]) <= WINDOW)
             & (kpos[:, None, :] >= 0) & (kpos[:, None, :] < length))
    s_loc = jnp.einsum('bnqhrd,bnkhd->bnhrqk', qb, kw) * scale
    s_loc = jnp.where(valid[None, :, None, None], s_loc, NEG_INF)
    s_ctx = jnp.einsum('bnqhrd,bchd->bnhrqc', qb, kc.astype(jnp.float32)) * scale
    sink_b = sink.astype(jnp.float32).reshape(N_KV, Q_PER_KV)[None, None, :, :, None, None]
    snk = jnp.broadcast_to(sink_b, s_loc.shape[:-1] + (1,))
    p = jax.nn.softmax(jnp.concatenate([s_loc, s_ctx, snk], axis=-1), axis=-1)
    out = (jnp.einsum('bnhrqk,bnkhd->bnqhrd', p[..., :nw], vw)
           + jnp.einsum('bnhrqc,bchd->bnqhrd', p[..., nw:nw + lc], vc.astype(jnp.float32)))
    return out.reshape(b, length, ATT_WIDTH).astype(q.dtype)


def _ssm_combine(e1, e2):
    a1, b1 = e1
    a2, b2 = e2
    return a2 * a1, a2 * b1 + b2


def s5_scan(u, lam_re, lam_im, log_step, b_re, b_im, c_re, c_im, h0, reverse):
    lam = lax.complex(lam_re.astype(jnp.float32), lam_im.astype(jnp.float32))
    dt = jnp.exp(log_step.astype(jnp.float32))[:, None]
    lam_bar = jnp.exp(lam * dt)
    b_bar = ((lam_bar - 1.0) / lam)[..., None] * lax.complex(b_re.astype(jnp.float32), b_im.astype(jnp.float32))
    bu = jnp.einsum('blgh,gph->blgp', u.astype(jnp.complex64), b_bar)
    if reverse:
        bu = jnp.flip(bu, axis=1)
    bu = bu.at[:, 0].add(lam_bar * h0)
    a = jnp.broadcast_to(lam_bar, bu.shape)
    _, h = lax.associative_scan(_ssm_combine, (a, bu), axis=1)
    h_last = h[:, -1]
    if reverse:
        h = jnp.flip(h, axis=1)
    c_mat = lax.complex(c_re.astype(jnp.float32), c_im.astype(jnp.float32))
    y = jnp.einsum('blgp,ghp->blgh', h, c_mat).real
    return y, h_last


def hybrid_mixer(xm, lp, ctx):
    b, length, _ = xm.shape
    z = xm @ lp['w_in']
    split_at = [int(i) for i in np.cumsum(IN_SIZES)[:-1]]
    zf, zb, zc, zh, zs, zq, zk, zv, zg = jnp.split(z, split_at, axis=-1)

    zf4 = zf.reshape(b, length, FFT_GROUPS, FFT_GROUP_CH).astype(jnp.float32)
    y_fft = jnp.fft.fft2(zf4, axes=(1, 3), norm='ortho').real.reshape(b, length, FFT_WIDTH).astype(xm.dtype)

    g = zc * zh
    conv = lax.conv_general_dilated(g, lp['conv_w'][:, None, :], window_strides=(1,),
                                    padding=((CONV_K // 2, CONV_K // 2),),
                                    dimension_numbers=('NWC', 'WIO', 'NWC'),
                                    feature_group_count=CONV_WIDTH)
    y_conv = zb * conv

    u = zs.reshape(b, length, SSM_GROUPS, SSM_CH).astype(jnp.float32)
    if ctx is None:
        h0f = jnp.zeros((b, SSM_GROUPS, SSM_STATE), jnp.complex64)
        h0b = h0f
    else:
        h0f, h0b = ctx[2], ctx[3]
    yf, hf = s5_scan(u, lp['lam_re'][0], lp['lam_im'][0], lp['log_step'][0], lp['b_re'][0], lp['b_im'][0],
                     lp['c_re'][0], lp['c_im'][0], h0f, False)
    yb, hb = s5_scan(u, lp['lam_re'][1], lp['lam_im'][1], lp['log_step'][1], lp['b_re'][1], lp['b_im'][1],
                     lp['c_re'][1], lp['c_im'][1], h0b, True)
    ys = (yf + yb).reshape(b, length, SSM_WIDTH) + lp['ssm_d'].astype(jnp.float32) * zs.astype(jnp.float32)
    ys = jax.nn.gelu(ys).astype(xm.dtype)
    y_ssm = ys * jax.nn.sigmoid(ys @ lp['w_glu'])

    q = zq.reshape(b, length, N_KV, Q_PER_KV, HEAD_DIM)
    k = zk.reshape(b, length, N_KV, HEAD_DIM)
    v = zv.reshape(b, length, N_KV, HEAD_DIM)
    if ctx is None:
        y_att = context_attention(q, k, v, lp['sink'])
    else:
        cos, sin = axial_rope(length)
        y_att = latent_attention(apply_rope(q, cos, sin), apply_rope(k, cos, sin), v, ctx[0], ctx[1], lp['sink'])

    branches = jnp.stack([y_fft, y_conv, y_ssm, y_att], axis=2)
    proj = jnp.einsum('blnc,ncd->blnd', branches, lp['w_branch'])
    gates = jax.nn.sigmoid(zg.reshape(b, length, N_BRANCH, D_MODEL))
    out = jnp.sum(gates * proj, axis=2) @ lp['w_out']
    return out, k, v, hf, hb


def peer_ffn(xm, wq, subkeys, u_tab, v_tab):
    b, length, d = xm.shape
    t = b * length
    xf = xm.reshape(t, d)
    q = (xf @ wq).reshape(t, PEER_HEADS, 2, KEY_DIM // 2).astype(jnp.float32)
    s = jnp.einsum('thcd,hcnd->thcn', q, subkeys.astype(jnp.float32))
    s1, i1 = lax.top_k(s[:, :, 0], PEER_TOPK)
    s2, i2 = lax.top_k(s[:, :, 1], PEER_TOPK)
    cand = (s1[..., :, None] + s2[..., None, :]).reshape(t, PEER_HEADS, PEER_TOPK * PEER_TOPK)
    cidx = (i1[..., :, None] * N_KEYS + i2[..., None, :]).reshape(t, PEER_HEADS, PEER_TOPK * PEER_TOPK)
    best, pos = lax.top_k(cand, PEER_TOPK)
    idx = jnp.take_along_axis(cidx, pos, axis=-1)
    gate = jax.nn.softmax(best, axis=-1).astype(xm.dtype)
    nchunk = t // PEER_CHUNK

    def chunk(args):
        xc, ic, gc = args
        hc = jax.nn.gelu(jnp.einsum('cd,chkd->chk', xc, u_tab[ic]))
        return jnp.einsum('chk,chkd->cd', gc * hc, v_tab[ic])

    out = lax.map(chunk, (xf.reshape(nchunk, PEER_CHUNK, d),
                          idx.reshape(nchunk, PEER_CHUNK, PEER_HEADS, PEER_TOPK),
                          gate.reshape(nchunk, PEER_CHUNK, PEER_HEADS, PEER_TOPK)))
    return out.reshape(b, length, d)


def trunk_layer(x, cvec, lp, ctx):
    sh1, sc1, g1, sh2, sc2, g2 = modulation(cvec, lp['w_ada'], lp['b_ada'])
    mix, k, v, hf, hb = hybrid_mixer(x * (1 + sc1) + sh1, lp, ctx)
    x = layer_norm(DEEPNORM_ALPHA * x + g1 * mix, lp['ln1_g'], lp['ln1_b'])
    ff = peer_ffn(x * (1 + sc2) + sh2, lp['peer_wq'], lp['peer_subkeys'], lp['peer_u'], lp['peer_v'])
    x = layer_norm(DEEPNORM_ALPHA * x + g2 * ff, lp['ln2_g'], lp['ln2_b'])
    return x, k, v, hf, hb


def setup_inputs(seed: int = 0) -> dict:
    key = jax.random.key(seed)
    ks = jax.random.split(key, 40)
    f32 = jnp.float32

    def nrm(k, shape, std):
        return jax.random.normal(k, shape, f32) * std

    lam_im_base = jnp.pi * jnp.arange(SSM_STATE, dtype=f32)
    return {
        "x_prompt": nrm(ks[0], (BATCH, SEQ, D_MODEL), 1.0),
        "x_sample": nrm(ks[1], (DEC_BATCH, DEC_SEQ, D_MODEL), 1.0),
        "cache_k": nrm(ks[2], (DEC_BATCH, DEPTH, PAST_LEN, N_KV, HEAD_DIM), 1.0),
        "cache_v": nrm(ks[3], (DEC_BATCH, DEPTH, PAST_LEN, N_KV, HEAD_DIM), 1.0),
        "state_ssm_re": nrm(ks[4], (DEC_BATCH, DEPTH, 2, SSM_GROUPS, SSM_STATE), 0.3),
        "state_ssm_im": nrm(ks[5], (DEC_BATCH, DEPTH, 2, SSM_GROUPS, SSM_STATE), 0.3),
        "c": nrm(ks[6], (DEC_BATCH, D_MODEL), 1.0),
        "c_ctx": nrm(ks[7], (D_MODEL,), 1.0),
        "w_ada": nrm(ks[8], (DEPTH, D_MODEL, 6 * D_MODEL), 0.5 * D_MODEL ** -0.5),
        "b_ada": nrm(ks[9], (DEPTH, 6 * D_MODEL), 0.01),
        "w_in": nrm(ks[10], (DEPTH, D_MODEL, IN_COLS), D_MODEL ** -0.5),
        "conv_w": nrm(ks[11], (DEPTH, CONV_K, CONV_WIDTH), CONV_K ** -0.5),
        "ssm_lam_re": -0.5 + nrm(ks[12], (DEPTH, 2, SSM_GROUPS, SSM_STATE), 0.01),
        "ssm_lam_im": lam_im_base + nrm(ks[13], (DEPTH, 2, SSM_GROUPS, SSM_STATE), 0.01),
        "ssm_log_step": jax.random.uniform(ks[14], (DEPTH, 2, SSM_GROUPS), f32,
                                           minval=math.log(1e-3), maxval=math.log(1e-1)),
        "ssm_b_re": nrm(ks[15], (DEPTH, 2, SSM_GROUPS, SSM_STATE, SSM_CH), (2 * SSM_CH) ** -0.5),
        "ssm_b_im": nrm(ks[16], (DEPTH, 2, SSM_GROUPS, SSM_STATE, SSM_CH), (2 * SSM_CH) ** -0.5),
        "ssm_c_re": nrm(ks[17], (DEPTH, 2, SSM_GROUPS, SSM_CH, SSM_STATE), (2 * SSM_STATE) ** -0.5),
        "ssm_c_im": nrm(ks[18], (DEPTH, 2, SSM_GROUPS, SSM_CH, SSM_STATE), (2 * SSM_STATE) ** -0.5),
        "ssm_d": nrm(ks[19], (DEPTH, SSM_WIDTH), 1.0),
        "ssm_w_glu": nrm(ks[20], (DEPTH, SSM_WIDTH, SSM_WIDTH), SSM_WIDTH ** -0.5),
        "attn_sink": nrm(ks[21], (DEPTH, N_HEADS), 0.5),
        "w_branch": nrm(ks[22], (DEPTH, N_BRANCH, BRANCH_WIDTH, D_MODEL), BRANCH_WIDTH ** -0.5),
        "w_out": nrm(ks[23], (DEPTH, D_MODEL, D_MODEL), DEEPNORM_BETA * D_MODEL ** -0.5),
        "ln1_g": 1.0 + nrm(ks[24], (DEPTH, D_MODEL), 0.01),
        "ln1_b": nrm(ks[25], (DEPTH, D_MODEL), 0.01),
        "ln2_g": 1.0 + nrm(ks[26], (DEPTH, D_MODEL), 0.01),
        "ln2_b": nrm(ks[27], (DEPTH, D_MODEL), 0.01),
        "peer_wq": nrm(ks[28], (DEPTH, D_MODEL, PEER_HEADS * KEY_DIM), D_MODEL ** -0.5),
        "peer_subkeys": nrm(ks[29], (DEPTH, PEER_HEADS, 2, N_KEYS, KEY_DIM // 2), (KEY_DIM // 2) ** -0.5),
        "peer_u": nrm(ks[30], (DEPTH, N_EXPERTS, D_MODEL), D_MODEL ** -0.5),
        "peer_v": nrm(ks[31], (DEPTH, N_EXPERTS, D_MODEL), DEEPNORM_BETA * PEER_HEADS ** -0.5),
    }


def reference(x_prompt, x_sample, cache_k, cache_v, state_ssm_re, state_ssm_im, c, c_ctx,
              w_ada, b_ada, w_in, conv_w, ssm_lam_re, ssm_lam_im, ssm_log_step,
              ssm_b_re, ssm_b_im, ssm_c_re, ssm_c_im, ssm_d, ssm_w_glu, attn_sink,
              w_branch, w_out, ln1_g, ln1_b, ln2_g, ln2_b,
              peer_wq, peer_subkeys, peer_u, peer_v):
    xp = x_prompt
    xs = x_sample
    cvec_ctx = c_ctx[None, :]
    new_k, new_v, new_re, new_im = [], [], [], []
    for l in range(DEPTH):
        lp = {
            'w_ada': w_ada[l], 'b_ada': b_ada[l], 'w_in': w_in[l], 'conv_w': conv_w[l],
            'lam_re': ssm_lam_re[l], 'lam_im': ssm_lam_im[l], 'log_step': ssm_log_step[l],
            'b_re': ssm_b_re[l], 'b_im': ssm_b_im[l], 'c_re': ssm_c_re[l], 'c_im': ssm_c_im[l],
            'ssm_d': ssm_d[l], 'w_glu': ssm_w_glu[l], 'sink': attn_sink[l],
            'w_branch': w_branch[l], 'w_out': w_out[l],
            'ln1_g': ln1_g[l], 'ln1_b': ln1_b[l], 'ln2_g': ln2_g[l], 'ln2_b': ln2_b[l],
            'peer_wq': peer_wq[l], 'peer_subkeys': peer_subkeys[l], 'peer_u': peer_u[l], 'peer_v': peer_v[l],
        }
        xp, k_l, v_l, hf, hb = trunk_layer(xp, cvec_ctx, lp, None)
        new_k.append(k_l)
        new_v.append(v_l)
        new_re.append(jnp.stack([hf.real, hb.real], axis=1))
        new_im.append(jnp.stack([hf.imag, hb.imag], axis=1))
        h0f = lax.complex(state_ssm_re[:, l, 0].astype(jnp.float32), state_ssm_im[:, l, 0].astype(jnp.float32))
        h0b = lax.complex(state_ssm_re[:, l, 1].astype(jnp.float32), state_ssm_im[:, l, 1].astype(jnp.float32))
        xs, _, _, _, _ = trunk_layer(xs, c, lp, (cache_k[:, l], cache_v[:, l], h0f, h0b))
    new_cache_k = jnp.stack(new_k, axis=1)
    new_cache_v = jnp.stack(new_v, axis=1)
    new_state_re = jnp.stack(new_re, axis=1)
    new_state_im = jnp.stack(new_im, axis=1)
    return (xp, xs, new_cache_k, new_cache_v, new_state_re, new_state_im)
```

```cpp
#include <hip/hip_runtime.h>
#include <hip/hip_cooperative_groups.h>
#include <cstdio>
#include <cstdint>
namespace cg = cooperative_groups;

typedef unsigned short u16;
typedef unsigned int u32;
typedef __attribute__((ext_vector_type(8))) short bf16x8;
typedef __attribute__((ext_vector_type(4))) float f32x4;
typedef __attribute__((ext_vector_type(4))) unsigned int u32x4;
typedef __attribute__((ext_vector_type(2))) unsigned int u32x2;
typedef __attribute__((ext_vector_type(4))) int i32x4;
typedef __attribute__((ext_vector_type(2))) __bf16 bf16x2;


#ifndef MULTI_LAUNCH
#define MULTI_LAUNCH 0
#endif

#define T_CTX 8192
#define T_LAT 4096
#define T_ALL 12288
#define DM 1024
#define NCOL 7424
#define DEPTH 4
#define ALPHA 1.6817928305074290f
#define LN_EPS 1e-5f

struct Params {
  const float *x_prompt, *x_sample, *cache_k, *cache_v, *st_re, *st_im, *c, *c_ctx, *w_ada, *b_ada, *w_in, *conv_w,
      *lam_re, *lam_im, *log_step, *b_re, *b_im, *c_re, *c_im, *ssm_d, *w_glu, *sink, *w_branch, *w_out,
      *ln1_g, *ln1_b, *ln2_g, *ln2_b, *peer_wq, *subkeys, *peer_u, *peer_v;
  float* out;
  u16 *U16, *V16, *WinT, *WbrT, *WoutT, *WqT, *WgluT, *SK16, *FC, *FL256, *FL1024, *CK16, *CVT16;
  float *MOD, *ROPE;
  float *X, *X1;
  u16 *XM, *XM2;
  u16 *ZF, *ZCV;
  float* ZS;
  u16 *Q16, *K16, *VT, *G, *TTt, *Y4, *YS, *MERGED;
  float *YBK, *R1;
  u16* PQ;
  float* SC;
  int* PIDX;
  float* PG;
  unsigned char *U8, *V8;
  unsigned char *XM8, *WgT8;
  float *SCU, *SCV;
  unsigned* bar;
};
typedef const __attribute__((address_space(4))) Params KParams;
#define KP KParams&


__device__ __forceinline__ int tidx() { int t = threadIdx.x; asm volatile("" : "+v"(t)); return t; }
__device__ __forceinline__ int wave_id() { return __builtin_amdgcn_readfirstlane(tidx() >> 6); }
__device__ __forceinline__ int bidx() { int b = blockIdx.x; asm volatile("" : "+s"(b)); return b; }
typedef __attribute__((ext_vector_type(2))) float f32x2;
__device__ __forceinline__ u32 pack_bf16(float lo, float hi) {
  bf16x2 v = __builtin_convertvector((f32x2){lo, hi}, bf16x2);
  return __builtin_bit_cast(u32, v);
}
__device__ __forceinline__ float bf_lo(u32 u) { return __uint_as_float(u << 16); }
__device__ __forceinline__ float bf_hi(u32 u) { return __uint_as_float(u & 0xffff0000u); }
__device__ __forceinline__ float sigmoid_f(float x) { return 1.f / (1.f + __expf(-x)); }
__device__ __forceinline__ float gelu_tanh(float x) {
  float y = 0.7978845608028654f * (x + 0.044715f * x * x * x);
  return x * sigmoid_f(2.f * y);
}
__device__ __forceinline__ float dot2bf(u32 a, u32 b, float acc) {
  return __builtin_amdgcn_fdot2_f32_bf16(__builtin_bit_cast(bf16x2, a), __builtin_bit_cast(bf16x2, b), acc, false);
}
__device__ __forceinline__ bf16x8 as_bf16x8(u32x4 v) { return __builtin_bit_cast(bf16x8, v); }
__device__ __forceinline__ float wave_sum(float v) {
#pragma unroll
  for (int o = 32; o >= 1; o >>= 1) v += __shfl_xor(v, o, 64);
  return v;
}
__device__ __forceinline__ int mod_group(int t) { return t < T_CTX ? 0 : 1 + ((t - T_CTX) >> 10); }

#define LSTR 72
template <int NJ>
__device__ __forceinline__ void gemm_mainloop_t(const u16* __restrict__ A, size_t lda, const u16* __restrict__ Bt, size_t ldb,
                                                int K, f32x4 (&acc)[4][NJ], char* smem) {
  u16* sA = (u16*)smem;
  u16* sB = sA + 128 * LSTR;
  const int tid = tidx(), lane = tid & 63, wave = tid >> 6;
  const int wm = (wave >> 1) * 64, wn = (wave & 1) * (16 * NJ);
#pragma unroll
  for (int i = 0; i < 4; ++i)
#pragma unroll
    for (int j = 0; j < NJ; ++j) acc[i][j] = (f32x4){0.f, 0.f, 0.f, 0.f};
  u32x4 ra[4], rb[NJ];
  const int lr = tid >> 3, lc = (tid & 7) * 8;
  const u16* ap = A + (size_t)lr * lda + lc;
  const u16* bp = Bt + (size_t)lr * ldb + lc;
#pragma unroll
  for (int i = 0; i < 4; ++i) ra[i] = *(const u32x4*)(ap + (size_t)(i * 32) * lda);
#pragma unroll
  for (int i = 0; i < NJ; ++i) rb[i] = *(const u32x4*)(bp + (size_t)(i * 32) * ldb);
  for (int k0 = 0; k0 < K; k0 += 64) {
    __syncthreads();
#pragma unroll
    for (int i = 0; i < 4; ++i) *(u32x4*)(sA + (lr + i * 32) * LSTR + lc) = ra[i];
#pragma unroll
    for (int i = 0; i < NJ; ++i) *(u32x4*)(sB + (lr + i * 32) * LSTR + lc) = rb[i];
    __syncthreads();
    if (k0 + 64 < K) {
#pragma unroll
      for (int i = 0; i < 4; ++i) ra[i] = *(const u32x4*)(ap + (size_t)(i * 32) * lda + k0 + 64);
#pragma unroll
      for (int i = 0; i < NJ; ++i) rb[i] = *(const u32x4*)(bp + (size_t)(i * 32) * ldb + k0 + 64);
    }
    __builtin_amdgcn_s_setprio(1);
#pragma unroll
    for (int ks = 0; ks < 2; ++ks) {
      bf16x8 af[4], bfr[NJ];
      const int koff = ks * 32 + (lane >> 4) * 8;
#pragma unroll
      for (int i = 0; i < 4; ++i) af[i] = *(const bf16x8*)(sA + (wm + i * 16 + (lane & 15)) * LSTR + koff);
#pragma unroll
      for (int j = 0; j < NJ; ++j) bfr[j] = *(const bf16x8*)(sB + (wn + j * 16 + (lane & 15)) * LSTR + koff);
#pragma unroll
      for (int i = 0; i < 4; ++i)
#pragma unroll
        for (int j = 0; j < NJ; ++j)
          acc[i][j] = __builtin_amdgcn_mfma_f32_16x16x32_bf16(bfr[j], af[i], acc[i][j], 0, 0, 0);
    }
    __builtin_amdgcn_s_setprio(0);
  }
  __syncthreads();
}
__device__ __forceinline__ void gemm_mainloop(const u16* __restrict__ A, size_t lda, const u16* __restrict__ Bt, size_t ldb,
                                              int K, f32x4 (&acc)[4][4], char* smem) {
  gemm_mainloop_t<4>(A, lda, Bt, ldb, K, acc, smem);
}

__device__ __forceinline__ void gemm_mainloop_big(const u16* __restrict__ A, size_t lda, const u16* __restrict__ Bt, size_t ldb,
                                                  int K, f32x4 (&acc)[8][4], char* smem) {
  u16* sA = (u16*)smem;
  u16* sB = sA + 256 * LSTR;
  const int tid = tidx(), lane = tid & 63, wave = tid >> 6;
  const int wm = (wave >> 1) * 128, wn = (wave & 1) * 64;
#pragma unroll
  for (int i = 0; i < 8; ++i)
#pragma unroll
    for (int j = 0; j < 4; ++j) acc[i][j] = (f32x4){0.f, 0.f, 0.f, 0.f};
  u32x4 ra[8], rb[4];
  const int lr = tid >> 3, lc = (tid & 7) * 8;
  const u16* ap = A + (size_t)lr * lda + lc;
  const u16* bp = Bt + (size_t)lr * ldb + lc;
#pragma unroll
  for (int i = 0; i < 8; ++i) ra[i] = *(const u32x4*)(ap + (size_t)(i * 32) * lda);
#pragma unroll
  for (int i = 0; i < 4; ++i) rb[i] = *(const u32x4*)(bp + (size_t)(i * 32) * ldb);
  for (int k0 = 0; k0 < K; k0 += 64) {
    __syncthreads();
#pragma unroll
    for (int i = 0; i < 8; ++i) *(u32x4*)(sA + (lr + i * 32) * LSTR + lc) = ra[i];
#pragma unroll
    for (int i = 0; i < 4; ++i) *(u32x4*)(sB + (lr + i * 32) * LSTR + lc) = rb[i];
    __syncthreads();
    if (k0 + 64 < K) {
#pragma unroll
      for (int i = 0; i < 8; ++i) ra[i] = *(const u32x4*)(ap + (size_t)(i * 32) * lda + k0 + 64);
#pragma unroll
      for (int i = 0; i < 4; ++i) rb[i] = *(const u32x4*)(bp + (size_t)(i * 32) * ldb + k0 + 64);
    }
    __builtin_amdgcn_s_setprio(1);
#pragma unroll
    for (int ks = 0; ks < 2; ++ks) {
      const int koff = ks * 32 + (lane >> 4) * 8;
      bf16x8 bfr[4];
#pragma unroll
      for (int j = 0; j < 4; ++j) bfr[j] = *(const bf16x8*)(sB + (wn + j * 16 + (lane & 15)) * LSTR + koff);
#pragma unroll
      for (int i = 0; i < 8; ++i) {
        const bf16x8 af = *(const bf16x8*)(sA + (wm + i * 16 + (lane & 15)) * LSTR + koff);
#pragma unroll
        for (int j = 0; j < 4; ++j)
          acc[i][j] = __builtin_amdgcn_mfma_f32_16x16x32_bf16(bfr[j], af, acc[i][j], 0, 0, 0);
      }
    }
    __builtin_amdgcn_s_setprio(0);
  }
  __syncthreads();
}

__device__ __forceinline__ void gemm_mainloop_fp8(const unsigned char* __restrict__ A, size_t lda, const unsigned char* __restrict__ Bt, size_t ldb,
                                                  int K, f32x4 (&acc)[4][4], char* smem) {
  unsigned char* sA = (unsigned char*)smem;
  unsigned char* sB = sA + 128 * 144;
  const int tid = tidx(), lane = tid & 63, wave = tid >> 6;
  const int wm = (wave >> 1) * 64, wn = (wave & 1) * 64;
#pragma unroll
  for (int i = 0; i < 4; ++i)
#pragma unroll
    for (int j = 0; j < 4; ++j) acc[i][j] = (f32x4){0.f, 0.f, 0.f, 0.f};
  u32x4 ra[4], rb[4];
  const int lr = tid >> 3, lc = (tid & 7) * 16;
  const unsigned char* ap = A + (size_t)lr * lda + lc;
  const unsigned char* bp = Bt + (size_t)lr * ldb + lc;
#pragma unroll
  for (int i = 0; i < 4; ++i) {
    ra[i] = *(const u32x4*)(ap + (size_t)(i * 32) * lda);
    rb[i] = *(const u32x4*)(bp + (size_t)(i * 32) * ldb);
  }
  for (int k0 = 0; k0 < K; k0 += 128) {
    __syncthreads();
#pragma unroll
    for (int i = 0; i < 4; ++i) {
      *(u32x4*)(sA + (lr + i * 32) * 144 + lc) = ra[i];
      *(u32x4*)(sB + (lr + i * 32) * 144 + lc) = rb[i];
    }
    __syncthreads();
    if (k0 + 128 < K) {
#pragma unroll
      for (int i = 0; i < 4; ++i) {
        ra[i] = *(const u32x4*)(ap + (size_t)(i * 32) * lda + k0 + 128);
        rb[i] = *(const u32x4*)(bp + (size_t)(i * 32) * ldb + k0 + 128);
      }
    }
    __builtin_amdgcn_s_setprio(1);
#pragma unroll
    for (int ks = 0; ks < 4; ++ks) {
      const int koff = ks * 32 + (lane >> 4) * 8;
      long bfr[4];
#pragma unroll
      for (int j = 0; j < 4; ++j) bfr[j] = *(const long*)(sB + (wn + j * 16 + (lane & 15)) * 144 + koff);
#pragma unroll
      for (int i = 0; i < 4; ++i) {
        const long af = *(const long*)(sA + (wm + i * 16 + (lane & 15)) * 144 + koff);
#pragma unroll
        for (int j = 0; j < 4; ++j)
          acc[i][j] = __builtin_amdgcn_mfma_f32_16x16x32_fp8_fp8(bfr[j], af, acc[i][j], 0, 0, 0);
      }
    }
    __builtin_amdgcn_s_setprio(0);
  }
  __syncthreads();
}

#define EPI_SETUP                                                   \
  const int lane = tidx() & 63, wave = tidx() >> 6;       \
  const int wm = (wave >> 1) * 64, wn = (wave & 1) * 64;            \
  const int lm = lane & 15, ln4 = (lane >> 4) * 4;

__device__ __forceinline__ void store_bf4(u16* dst, f32x4 v) {
  u32x2 o;
  o.x = pack_bf16(v[0], v[1]);
  o.y = pack_bf16(v[2], v[3]);
  *(u32x2*)dst = o;
}

__device__ void transpose_job(const float* __restrict__ src, u16* __restrict__ dst, int K, int N, int nbatch, char* smem) {
  float* tile = (float*)smem;
  const int tk = K / 64, tn = N / 64;
  const int total = nbatch * tk * tn;
  const int tid = tidx();
  const int row0 = tid >> 4, col = (tid & 15) * 4;
  f32x4 v[4];
  int t = bidx();
  if (t < total) {
    int bb = t / (tk * tn), r = t % (tk * tn);
    const float* sp = src + (size_t)bb * K * N + (size_t)((r / tn) * 64) * N + (r % tn) * 64;
#pragma unroll
    for (int i = 0; i < 4; ++i) v[i] = *(const f32x4*)(sp + (size_t)(row0 + i * 16) * N + col);
  }
  for (; t < total; t += gridDim.x) {
    int bb = t / (tk * tn), r = t % (tk * tn);
    int kt = r / tn, nt = r % tn;
    u16* d = dst + (size_t)bb * K * N + (size_t)(nt * 64) * K + kt * 64;
    __syncthreads();
#pragma unroll
    for (int i = 0; i < 4; ++i) {
      int row = row0 + i * 16;
      tile[row * 65 + col + 0] = v[i][0];
      tile[row * 65 + col + 1] = v[i][1];
      tile[row * 65 + col + 2] = v[i][2];
      tile[row * 65 + col + 3] = v[i][3];
    }
    __syncthreads();
    const int tn2 = t + gridDim.x;
    if (tn2 < total) {
      int b2 = tn2 / (tk * tn), r2 = tn2 % (tk * tn);
      const float* sp = src + (size_t)b2 * K * N + (size_t)((r2 / tn) * 64) * N + (r2 % tn) * 64;
#pragma unroll
      for (int i = 0; i < 4; ++i) v[i] = *(const f32x4*)(sp + (size_t)(row0 + i * 16) * N + col);
    }
    int n = tid >> 2, kc = (tid & 3) * 16;
    u32 o[8];
#pragma unroll
    for (int i = 0; i < 8; ++i) o[i] = pack_bf16(tile[(kc + 2 * i) * 65 + n], tile[(kc + 2 * i + 1) * 65 + n]);
    *(u32x4*)(d + (size_t)n * K + kc) = (u32x4){o[0], o[1], o[2], o[3]};
    *(u32x4*)(d + (size_t)n * K + kc + 8) = (u32x4){o[4], o[5], o[6], o[7]};
  }
}

__device__ void transpose_fp8_job(const float* __restrict__ src, size_t ld_src, size_t batch_stride, unsigned char* __restrict__ dst,
                                  int K, int N, int nbatch, float scale, char* smem) {
  float* tile = (float*)smem;
  const int tk = K / 64, tn = N / 64;
  const int total = nbatch * tk * tn;
  const int tid = tidx();
  for (int t = bidx(); t < total; t += gridDim.x) {
    int bb = t / (tk * tn), r = t % (tk * tn);
    int kt = r / tn, nt = r % tn;
    const float* sp = src + (size_t)bb * batch_stride + (size_t)(kt * 64) * ld_src + nt * 64;
    unsigned char* d = dst + (size_t)bb * K * N + (size_t)(nt * 64) * K + kt * 64;
    __syncthreads();
#pragma unroll
    for (int i = 0; i < 4; ++i) {
      int row = (tid >> 4) + i * 16, col = (tid & 15) * 4;
      f32x4 v = *(const f32x4*)(sp + (size_t)row * ld_src + col);
      tile[row * 65 + col + 0] = v[0];
      tile[row * 65 + col + 1] = v[1];
      tile[row * 65 + col + 2] = v[2];
      tile[row * 65 + col + 3] = v[3];
    }
    __syncthreads();
    int n = tid >> 2, kc = (tid & 3) * 16;
    u32x4 q;
    int w;
#pragma unroll
    for (int g4 = 0; g4 < 4; ++g4) {
      w = 0;
      w = __builtin_amdgcn_cvt_pk_fp8_f32(tile[(kc + g4 * 4 + 0) * 65 + n] * scale, tile[(kc + g4 * 4 + 1) * 65 + n] * scale, w, false);
      w = __builtin_amdgcn_cvt_pk_fp8_f32(tile[(kc + g4 * 4 + 2) * 65 + n] * scale, tile[(kc + g4 * 4 + 3) * 65 + n] * scale, w, true);
      q[g4] = (u32)w;
    }
    *(u32x4*)(d + (size_t)n * K + kc) = q;
  }
}

__device__ void convert_job(const float* __restrict__ src, u16* __restrict__ dst, size_t n) {
  size_t n8 = n / 8;
  for (size_t i = (size_t)bidx() * blockDim.x + tidx(); i < n8; i += (size_t)gridDim.x * blockDim.x) {
    f32x4 a = *(const f32x4*)(src + i * 8), b = *(const f32x4*)(src + i * 8 + 4);
    *(u32x4*)(dst + i * 8) = (u32x4){pack_bf16(a.x, a.y), pack_bf16(a.z, a.w), pack_bf16(b.x, b.y), pack_bf16(b.z, b.w)};
  }
}


typedef __attribute__((ext_vector_type(2))) float f32x2_t;
__device__ void fp8_rows_job(const float* __restrict__ src, unsigned char* __restrict__ dst, float* __restrict__ inv_scale, int nrows, int skip_blocks) {
  const int lane = tidx() & 63;
  const int gw = (bidx() - skip_blocks) * 4 + (tidx() >> 6), nw = ((int)gridDim.x - skip_blocks) * 4;
  if (gw < 0) return;
  f32x4 n0 = {0.f, 0.f, 0.f, 0.f}, n1 = n0, n2 = n0, n3 = n0;
  if (gw < nrows) {
    const float* row = src + (size_t)gw * 1024 + lane * 16;
    n0 = *(const f32x4*)row; n1 = *(const f32x4*)(row + 4); n2 = *(const f32x4*)(row + 8); n3 = *(const f32x4*)(row + 12);
  }
  for (int r = gw; r < nrows; r += nw) {
    const f32x4 v0 = n0, v1 = n1, v2 = n2, v3 = n3;
    if (r + nw < nrows) {
      const float* row = src + (size_t)(r + nw) * 1024 + lane * 16;
      n0 = *(const f32x4*)row; n1 = *(const f32x4*)(row + 4); n2 = *(const f32x4*)(row + 8); n3 = *(const f32x4*)(row + 12);
    }
    float am = 0.f;
#pragma unroll
    for (int k = 0; k < 4; ++k) am = fmaxf(am, fmaxf(fmaxf(fabsf(v0[k]), fabsf(v1[k])), fmaxf(fabsf(v2[k]), fabsf(v3[k]))));
#pragma unroll
    for (int o = 32; o >= 1; o >>= 1) am = fmaxf(am, __shfl_xor(am, o, 64));
    am = fmaxf(am, 1e-30f);
    const float sc = 448.f / am;
    u32x4 q;
    int w;
    w = 0; w = __builtin_amdgcn_cvt_pk_fp8_f32(v0[0] * sc, v0[1] * sc, w, false); w = __builtin_amdgcn_cvt_pk_fp8_f32(v0[2] * sc, v0[3] * sc, w, true); q.x = (u32)w;
    w = 0; w = __builtin_amdgcn_cvt_pk_fp8_f32(v1[0] * sc, v1[1] * sc, w, false); w = __builtin_amdgcn_cvt_pk_fp8_f32(v1[2] * sc, v1[3] * sc, w, true); q.y = (u32)w;
    w = 0; w = __builtin_amdgcn_cvt_pk_fp8_f32(v2[0] * sc, v2[1] * sc, w, false); w = __builtin_amdgcn_cvt_pk_fp8_f32(v2[2] * sc, v2[3] * sc, w, true); q.z = (u32)w;
    w = 0; w = __builtin_amdgcn_cvt_pk_fp8_f32(v3[0] * sc, v3[1] * sc, w, false); w = __builtin_amdgcn_cvt_pk_fp8_f32(v3[2] * sc, v3[3] * sc, w, true); q.w = (u32)w;
    *(u32x4*)(dst + (size_t)r * 2048 + lane * 16) = q;
    if (lane == 0) inv_scale[r] = am * (1.f / 448.f);
  }
}

__device__ void mod_job(KP p, char* smem) {
  float* sc = (float*)smem;
  float* red = sc + 5 * 1024;
  const int tid = tidx();
  for (int task = bidx(); task < DEPTH * 96; task += gridDim.x) {
    int l = task / 96, n0 = (task % 96) * 64;
    __syncthreads();
    for (int i = tid; i < 5 * 1024; i += 256) {
      int g = i >> 10, k = i & 1023;
      float v = g == 0 ? p.c_ctx[k] : p.c[(g - 1) * 1024 + k];
      sc[i] = v * sigmoid_f(v);
    }
    __syncthreads();
    int kc = tid >> 6, n = tid & 63;
    const float* w = p.w_ada + (size_t)l * 1024 * 6144 + (size_t)(kc * 256) * 6144 + n0 + n;
    float a0 = 0, a1 = 0, a2 = 0, a3 = 0, a4 = 0;
#pragma unroll 32
    for (int k = 0; k < 256; ++k) {
      float wv = w[(size_t)k * 6144];
      int kk = kc * 256 + k;
      a0 += sc[kk] * wv;
      a1 += sc[1024 + kk] * wv;
      a2 += sc[2048 + kk] * wv;
      a3 += sc[3072 + kk] * wv;
      a4 += sc[4096 + kk] * wv;
    }
    red[(kc * 5 + 0) * 64 + n] = a0;
    red[(kc * 5 + 1) * 64 + n] = a1;
    red[(kc * 5 + 2) * 64 + n] = a2;
    red[(kc * 5 + 3) * 64 + n] = a3;
    red[(kc * 5 + 4) * 64 + n] = a4;
    __syncthreads();
    for (int i = tid; i < 5 * 64; i += 256) {
      int g = i >> 6, nn = i & 63;
      float s = red[(0 * 5 + g) * 64 + nn] + red[(1 * 5 + g) * 64 + nn] + red[(2 * 5 + g) * 64 + nn] + red[(3 * 5 + g) * 64 + nn];
      p.MOD[((size_t)l * 5 + g) * 6144 + n0 + nn] = s + p.b_ada[l * 6144 + n0 + nn];
    }
  }
}

__device__ void tables_job(KP p) {
  const size_t gtid = (size_t)bidx() * blockDim.x + tidx(), gsz = (size_t)gridDim.x * blockDim.x;
  const float TWO_PI = 6.283185307179586f;
  for (size_t i = gtid; i < 256 * 128; i += gsz) {
    int m = (int)(i >> 7), c = (int)(i & 127);
    int cs = m >> 7, cp = m & 127;
    int r = (c * cp) & 127;
    float ang = TWO_PI * (float)r / 128.f;
    float v = cs ? __sinf(ang) : __cosf(ang);
    p.FC[i] = (u16)(pack_bf16(v, 0.f) & 0xffff);
  }
  for (size_t i = gtid; i < 256 * 512; i += gsz) {
    int lp = (int)(i >> 9), k = (int)(i & 511);
    int cs = k >> 8, l = k & 255;
    int r = (l * lp) & 255;
    float ang = TWO_PI * (float)r / 256.f;
    float sc = 0.005524271728019903f;
    float v = cs ? -__sinf(ang) * sc : __cosf(ang) * sc;
    p.FL256[i] = (u16)(pack_bf16(v, 0.f) & 0xffff);
  }
  for (size_t i = gtid; i < 1024 * 2048; i += gsz) {
    int lp = (int)(i >> 11), k = (int)(i & 2047);
    int cs = k >> 10, l = k & 1023;
    int r = (l * lp) & 1023;
    float ang = TWO_PI * (float)r / 1024.f;
    float sc = 0.0027621358640099515f;
    float v = cs ? -__sinf(ang) * sc : __cosf(ang) * sc;
    p.FL1024[i] = (u16)(pack_bf16(v, 0.f) & 0xffff);
  }
  for (size_t i = gtid; i < 1024; i += gsz) {
    int pos = (int)(i >> 4), f = (int)(i & 15);
    float inv = 1.0f / exp2f((float)f * (13.287712379549449f / 16.f));
    float ang = (float)pos * inv;
    p.ROPE[i] = cosf(ang);
    p.ROPE[1024 + i] = sinf(ang);
  }
  for (size_t i = gtid; i < 16 * 128 * 256; i += gsz) {
    int bl = (int)(i >> 15), r = (int)(i & 32767);
    int c = r >> 8, key = r & 255;
    float v = p.cache_v[((size_t)bl * 256 + key) * 128 + c];
    p.CVT16[i] = (u16)(pack_bf16(v, 0.f) & 0xffff);
  }
}

__device__ void prologue0(KP p, char* smem) {
  mod_job(p, smem);
  transpose_job(p.w_in, p.WinT, 1024, NCOL, DEPTH, smem);
  transpose_fp8_job(p.w_in + 3328, NCOL, (size_t)1024 * NCOL, p.WgT8, 1024, 4096, DEPTH, 64.f, smem);
  transpose_job(p.w_glu, p.WgluT, 512, 512, DEPTH, smem);
  transpose_job(p.w_branch, p.WbrT, 512, 1024, DEPTH * 4, smem);
  transpose_job(p.w_out, p.WoutT, 1024, 1024, DEPTH, smem);
  transpose_job(p.peer_wq, p.WqT, 1024, 2048, DEPTH, smem);
  tables_job(p);
  convert_job(p.subkeys, p.SK16, (size_t)DEPTH * 8 * 2 * 128 * 128);
  convert_job(p.cache_k, p.CK16, (size_t)4 * DEPTH * 256 * 128);
}

__device__ void prologue1(KP p) {
  const size_t n4 = (size_t)T_ALL * 256;
  for (size_t i = (size_t)bidx() * blockDim.x + tidx(); i < n4; i += (size_t)gridDim.x * blockDim.x) {
    int t = (int)(i >> 8), c = (int)(i & 255) * 4;
    const float* src = t < T_CTX ? p.x_prompt + (size_t)t * 1024 + c : p.x_sample + (size_t)(t - T_CTX) * 1024 + c;
    f32x4 v = *(const f32x4*)src;
    *(f32x4*)(p.X + (size_t)t * 1024 + c) = v;
    const float* mod = p.MOD + (size_t)mod_group(t) * 6144;
    f32x4 sh = *(const f32x4*)(mod + c), scl = *(const f32x4*)(mod + 1024 + c);
    u32x2 o;
    o.x = pack_bf16(v.x * (1.f + scl.x) + sh.x, v.y * (1.f + scl.y) + sh.y);
    o.y = pack_bf16(v.z * (1.f + scl.z) + sh.z, v.w * (1.f + scl.w) + sh.w);
    *(u32x2*)(p.XM + (size_t)t * 1024 + c) = o;
    {
      int w8 = 0;
      w8 = __builtin_amdgcn_cvt_pk_fp8_f32(v.x * (1.f + scl.x) + sh.x, v.y * (1.f + scl.y) + sh.y, w8, false);
      w8 = __builtin_amdgcn_cvt_pk_fp8_f32(v.z * (1.f + scl.z) + sh.z, v.w * (1.f + scl.w) + sh.w, w8, true);
      *(int*)(p.XM8 + (size_t)t * 1024 + c) = w8;
    }
  }
}

__device__ void phase_inproj(KP p, int layer, char* smem) {
  const u16* W = p.WinT + (size_t)layer * NCOL * DM;
  const int lane = tidx() & 63, wave = tidx() >> 6;
  const int wm = (wave >> 1) * 128, wn = (wave & 1) * 64;
  const int lm = lane & 15, ln4 = (lane >> 4) * 4;
  for (int tile = bidx(); tile < 48 * 26; tile += gridDim.x) {
    const int mt = tile % 48, nt = tile / 48;
    f32x4 acc[8][4];
    gemm_mainloop_big(p.XM + (size_t)mt * 256 * DM, DM, W + (size_t)nt * 128 * DM, DM, DM, acc, smem);
    const int n0 = nt * 128, t0 = mt * 256;
    const bool lat = t0 >= T_CTX;
    if (n0 < 512) {
#pragma unroll
      for (int i = 0; i < 8; ++i)
#pragma unroll
        for (int j = 0; j < 4; ++j)
          store_bf4(p.ZF + (size_t)(t0 + wm + i * 16 + lm) * 512 + n0 + wn + j * 16 + ln4, acc[i][j]);
    } else if (n0 < 2048) {
#pragma unroll
      for (int i = 0; i < 8; ++i)
#pragma unroll
        for (int j = 0; j < 4; ++j)
          store_bf4(p.ZCV + (size_t)(t0 + wm + i * 16 + lm) * 1536 + (n0 - 512) + wn + j * 16 + ln4, acc[i][j]);
    } else if (n0 < 2560) {
#pragma unroll
      for (int i = 0; i < 8; ++i)
#pragma unroll
        for (int j = 0; j < 4; ++j)
          *(f32x4*)(p.ZS + (size_t)(t0 + wm + i * 16 + lm) * 512 + (n0 - 2048) + wn + j * 16 + ln4) = acc[i][j];
    } else if (n0 < 3200) {
      const bool isq = n0 < 3072;
#pragma unroll
      for (int i = 0; i < 8; ++i) {
        const int t = t0 + wm + i * 16 + lm;
        const int l = (t - T_CTX) & 1023;
#pragma unroll
        for (int half = 0; half < 2; ++half) {
          f32x4 o1 = acc[i][half * 2], o2 = acc[i][half * 2 + 1];
          if (lat) {
            const int pos = half == 0 ? (l >> 6) : (l & 63);
            const f32x4 cs = *(const f32x4*)(p.ROPE + pos * 16 + ln4);
            const f32x4 sn = *(const f32x4*)(p.ROPE + 1024 + pos * 16 + ln4);
            const f32x4 x1 = o1, x2 = o2;
            o1 = x1 * cs - x2 * sn;
            o2 = x2 * cs + x1 * sn;
          }
          const int c = wn + half * 32 + ln4;
          if (isq) {
            store_bf4(p.Q16 + (size_t)t * 512 + (n0 - 2560) + c, o1);
            store_bf4(p.Q16 + (size_t)t * 512 + (n0 - 2560) + c + 16, o2);
          } else {
            store_bf4(p.K16 + (size_t)t * 128 + c, o1);
            store_bf4(p.K16 + (size_t)t * 128 + c + 16, o2);
            if (!lat) {
              const int b = t >> 8, ll = t & 255;
              float* ko = p.out + (size_t)12582912 + (((size_t)(b * DEPTH + layer) * 256 + ll) * 128 + c);
              *(f32x4*)ko = o1;
              *(f32x4*)(ko + 16) = o2;
            }
          }
        }
      }
    } else if (n0 < 3328) {
#pragma unroll
      for (int i = 0; i < 8; ++i)
#pragma unroll
        for (int j = 0; j < 4; ++j) {
          const int t = t0 + wm + i * 16 + lm, c = wn + j * 16 + ln4;
          if (!lat) {
            const int b = t >> 8, ll = t & 255;
            *(f32x4*)(p.out + (size_t)16777216 + (((size_t)(b * DEPTH + layer) * 256 + ll) * 128 + c)) = acc[i][j];
#pragma unroll
            for (int r = 0; r < 4; ++r)
              p.VT[((size_t)(b * 128 + c + r)) * 256 + ll] = (u16)(pack_bf16(acc[i][j][r], 0.f) & 0xffff);
          } else {
            const int b = (t - T_CTX) >> 10, ll = (t - T_CTX) & 1023;
#pragma unroll
            for (int r = 0; r < 4; ++r)
              p.VT[(size_t)T_CTX * 128 + ((size_t)(b * 128 + c + r)) * 1024 + ll] = (u16)(pack_bf16(acc[i][j][r], 0.f) & 0xffff);
          }
        }
    }
  }
}

__device__ void fft1_tile(KP p, int tile, char* smem) {
  EPI_SETUP
  int s, g, mt, ntile, L, tok0;
  u16* dst;
  if (tile < 256) {
    int sg = tile >> 4, r = tile & 15;
    s = sg >> 2; g = sg & 3; mt = r >> 3; ntile = r & 7; L = 1024; tok0 = T_CTX + s * 1024;
    dst = p.TTt + (size_t)T_CTX * 4 * 256 + (size_t)sg * 128 * 2048;
  } else {
    int tt = tile - 256;
    int sg = tt >> 2, r = tt & 3;
    s = sg >> 2; g = sg & 3; mt = r >> 1; ntile = r & 1; L = 256; tok0 = s * 256;
    dst = p.TTt + (size_t)sg * 128 * 512;
  }
  f32x4 acc[4][4];
  gemm_mainloop(p.FC + (size_t)mt * 128 * 128, 128, p.ZF + (size_t)(tok0 + ntile * 128) * 512 + g * 128, 512, 128, acc, smem);
#pragma unroll
  for (int i = 0; i < 4; ++i)
#pragma unroll
    for (int j = 0; j < 4; ++j) {
      int cp = wm + i * 16 + lm;
      int l = ntile * 128 + wn + j * 16 + ln4;
      store_bf4(dst + (size_t)cp * (2 * L) + mt * L + l, acc[i][j]);
    }
}

__device__ void conv_job(KP p, int layer, int chunk, int nchunks) {
  const float* cw = p.conv_w + (size_t)layer * 3 * 512;
  u16* Y = p.Y4 + (size_t)T_ALL * 512;
  const size_t total = (size_t)T_ALL * 64;
  for (size_t i = (size_t)chunk * 256 + tidx(); i < total; i += (size_t)nchunks * 256) {
    int t = (int)(i >> 6), ch = (int)(i & 63) * 8;
    int l, L;
    if (t < T_CTX) { l = t & 255; L = 256; } else { l = (t - T_CTX) & 1023; L = 1024; }
    const u16* row = p.ZCV + (size_t)t * 1536;
    u32x4 zb = *(const u32x4*)(row + ch);
    u32x4 c0 = *(const u32x4*)(row + 512 + ch), h0 = *(const u32x4*)(row + 1024 + ch);
    u32x4 cm = (u32x4){0, 0, 0, 0}, hm = cm, cp = cm, hp = cm;
    if (l > 0) { cm = *(const u32x4*)(row - 1536 + 512 + ch); hm = *(const u32x4*)(row - 1536 + 1024 + ch); }
    if (l < L - 1) { cp = *(const u32x4*)(row + 1536 + 512 + ch); hp = *(const u32x4*)(row + 1536 + 1024 + ch); }
    const u32* zbw = (const u32*)&zb; const u32* c0w = (const u32*)&c0; const u32* h0w = (const u32*)&h0;
    const u32* cmw = (const u32*)&cm; const u32* hmw = (const u32*)&hm; const u32* cpw = (const u32*)&cp; const u32* hpw = (const u32*)&hp;
    u32 o[4];
#pragma unroll
    for (int w = 0; w < 4; ++w) {
      int c = ch + w * 2;
      float r0 = bf_lo(zbw[w]) * (cw[c] * bf_lo(cmw[w]) * bf_lo(hmw[w]) + cw[512 + c] * bf_lo(c0w[w]) * bf_lo(h0w[w]) +
                                  cw[1024 + c] * bf_lo(cpw[w]) * bf_lo(hpw[w]));
      float r1 = bf_hi(zbw[w]) * (cw[c + 1] * bf_hi(cmw[w]) * bf_hi(hmw[w]) + cw[512 + c + 1] * bf_hi(c0w[w]) * bf_hi(h0w[w]) +
                                  cw[1024 + c + 1] * bf_hi(cpw[w]) * bf_hi(hpw[w]));
      o[w] = pack_bf16(r0, r1);
    }
    *(u32x4*)(Y + (size_t)t * 512 + ch) = (u32x4){o[0], o[1], o[2], o[3]};
  }
}

#define BU_STR 20
#define H_STR 68
__device__ __forceinline__ void s5_pass(KP p, int layer, const int DIR, int b, int g, int L, int tok0, bool lat, float* BU, u32* Hs,
                                        u16* __restrict__ ydst) {
  const int lane = tidx() & 63;
  const int lm = lane & 15, slab = lane >> 4;
  const int pidx = (layer * 2 + DIR) * 32 + g;
  const float dt = expf(p.log_step[pidx]);
  bf16x8 bfrag[8];
#pragma unroll
  for (int nt = 0; nt < 4; ++nt) {
    int st = nt * 16 + lm;
    float lr = p.lam_re[pidx * 64 + st], li = p.lam_im[pidx * 64 + st];
    float a = lr * dt, bb = li * dt;
    float em1 = expm1f(a);
    float sb, cb;
    sincosf(bb, &sb, &cb);
    float sh = sinf(0.5f * bb);
    float nr = em1 * cb - 2.f * sh * sh;
    float ni = (em1 + 1.f) * sb;
    float den = 1.f / (lr * lr + li * li);
    float cr = (nr * lr + ni * li) * den, ci = (ni * lr - nr * li) * den;
    u32x4 fre = (u32x4){0, 0, 0, 0}, fim = fre;
    if (slab < 2) {
      const float* br = p.b_re + ((size_t)pidx * 64 + st) * 16 + slab * 8;
      const float* bi = p.b_im + ((size_t)pidx * 64 + st) * 16 + slab * 8;
      f32x4 r0 = *(const f32x4*)br, r1 = *(const f32x4*)(br + 4), i0 = *(const f32x4*)bi, i1 = *(const f32x4*)(bi + 4);
      fre.x = pack_bf16(cr * r0.x - ci * i0.x, cr * r0.y - ci * i0.y);
      fre.y = pack_bf16(cr * r0.z - ci * i0.z, cr * r0.w - ci * i0.w);
      fre.z = pack_bf16(cr * r1.x - ci * i1.x, cr * r1.y - ci * i1.y);
      fre.w = pack_bf16(cr * r1.z - ci * i1.z, cr * r1.w - ci * i1.w);
      fim.x = pack_bf16(cr * i0.x + ci * r0.x, cr * i0.y + ci * r0.y);
      fim.y = pack_bf16(cr * i0.z + ci * r0.z, cr * i0.w + ci * r0.w);
      fim.z = pack_bf16(cr * i1.x + ci * r1.x, cr * i1.y + ci * r1.y);
      fim.w = pack_bf16(cr * i1.z + ci * r1.z, cr * i1.w + ci * r1.w);
    }
    bfrag[nt] = as_bf16x8(fre);
    bfrag[nt + 4] = as_bf16x8(fim);
  }
  bf16x8 cfrag[4];
#pragma unroll
  for (int ks = 0; ks < 4; ++ks) {
    const float* cr = p.c_re + ((size_t)pidx * 16 + lm) * 64 + ks * 16 + slab * 4;
    const float* ci = p.c_im + ((size_t)pidx * 16 + lm) * 64 + ks * 16 + slab * 4;
    f32x4 r = *(const f32x4*)cr, im = *(const f32x4*)ci;
    u32x4 f;
    f.x = pack_bf16(r.x, -im.x);
    f.y = pack_bf16(r.y, -im.y);
    f.z = pack_bf16(r.z, -im.z);
    f.w = pack_bf16(r.w, -im.w);
    cfrag[ks] = as_bf16x8(f);
  }
  float ar, ai;
  {
    float lr = p.lam_re[pidx * 64 + lane], li = p.lam_im[pidx * 64 + lane];
    float e = expf(lr * dt);
    float sb, cb;
    sincosf(li * dt, &sb, &cb);
    ar = e * cb; ai = e * sb;
  }
  float hr = 0.f, hi = 0.f;
  if (lat) {
    size_t o = (((size_t)(b * DEPTH + layer) * 2 + DIR) * 32 + g) * 64 + lane;
    hr = p.st_re[o]; hi = p.st_im[o];
  }
  const int nb = L / 16;
  const int tstep = DIR ? -16 : 16;
  int tb = DIR ? (L - 16) : 0;
  const float* ubase = p.ZS + (size_t)(tok0 + lm) * 512 + g * 16 + (slab & 1) * 8;
  f32x4 u0n = {0.f, 0.f, 0.f, 0.f}, u1n = u0n;
  if (slab < 2) { const float* up = ubase + (size_t)tb * 512; u0n = *(const f32x4*)up; u1n = *(const f32x4*)(up + 4); }
  for (int bi = 0; bi < nb; ++bi, tb += tstep) {
    u32x4 uf = (u32x4){0, 0, 0, 0};
    if (slab < 2) uf = (u32x4){pack_bf16(u0n.x, u0n.y), pack_bf16(u0n.z, u0n.w), pack_bf16(u1n.x, u1n.y), pack_bf16(u1n.z, u1n.w)};
    if (slab < 2 && bi + 1 < nb) { const float* up = ubase + (size_t)(tb + tstep) * 512; u0n = *(const f32x4*)up; u1n = *(const f32x4*)(up + 4); }
    bf16x8 ufrag = as_bf16x8(uf);
#pragma unroll
    for (int nt = 0; nt < 8; ++nt) {
      f32x4 z = {0.f, 0.f, 0.f, 0.f};
      f32x4 r = __builtin_amdgcn_mfma_f32_16x16x32_bf16(ufrag, bfrag[nt], z, 0, 0, 0);
      *(f32x4*)(BU + (nt * 16 + lm) * BU_STR + slab * 4) = r;
    }
    __syncthreads();
    float bre[16], bim[16];
#pragma unroll
    for (int q = 0; q < 4; ++q) {
      f32x4 a = *(const f32x4*)(BU + lane * BU_STR + q * 4);
      f32x4 c = *(const f32x4*)(BU + (64 + lane) * BU_STR + q * 4);
      bre[q * 4 + 0] = a[0]; bre[q * 4 + 1] = a[1]; bre[q * 4 + 2] = a[2]; bre[q * 4 + 3] = a[3];
      bim[q * 4 + 0] = c[0]; bim[q * 4 + 1] = c[1]; bim[q * 4 + 2] = c[2]; bim[q * 4 + 3] = c[3];
    }
    if (DIR) {
#pragma unroll
      for (int s = 15; s >= 0; --s) {
        float nr = ar * hr - ai * hi + bre[s];
        float ni = ar * hi + ai * hr + bim[s];
        hr = nr; hi = ni;
        Hs[s * H_STR + lane] = pack_bf16(hr, hi);
      }
    } else {
#pragma unroll
      for (int s = 0; s < 16; ++s) {
        float nr = ar * hr - ai * hi + bre[s];
        float ni = ar * hi + ai * hr + bim[s];
        hr = nr; hi = ni;
        Hs[s * H_STR + lane] = pack_bf16(hr, hi);
      }
    }
    __syncthreads();
    f32x4 y = {0.f, 0.f, 0.f, 0.f};
#pragma unroll
    for (int ks = 0; ks < 4; ++ks) {
      bf16x8 hf = *(const bf16x8*)(Hs + lm * H_STR + ks * 16 + slab * 4);
      y = __builtin_amdgcn_mfma_f32_16x16x32_bf16(cfrag[ks], hf, y, 0, 0, 0);
    }
    store_bf4(ydst + (size_t)(tok0 + tb + lm) * 512 + g * 16 + slab * 4, y);
  }
  if (!lat) {
    size_t o = (((size_t)(b * DEPTH + layer) * 2 + DIR) * 32 + g) * 64 + lane;
    p.out[(size_t)20971520 + o] = hr;
    p.out[(size_t)20971520 + 524288 + o] = hi;
  }
}

__device__ void s5_block(KP p, int layer, int btask, char* smem) {
  const int wave = tidx() >> 6;
  float* BU = (float*)(smem + wave * (128 * BU_STR * 4 + 16 * H_STR * 4));
  u32* Hs = (u32*)(BU + 128 * BU_STR);
  u16* YFW = p.MERGED;
  const bool lat = btask < 64;
  int b, g, L, tok0;
  if (lat) { const int task = (btask >> 1) * 4 + wave; b = task >> 5; g = task & 31; L = 1024; tok0 = T_CTX + b * 1024; }
  else { const int tt = (btask - 64) * 4 + wave; b = tt >> 5; g = tt & 31; L = 256; tok0 = b * 256; }
  const int npass = lat ? 1 : 2;
  for (int pass = 0; pass < npass; ++pass) {
    const int dir = lat ? (btask & 1) : (1 - pass);
    if (dir) s5_pass(p, layer, 1, b, g, L, tok0, lat, BU, Hs, (u16*)p.YBK);
    else s5_pass(p, layer, 0, b, g, L, tok0, lat, BU, Hs, YFW);
  }
}

struct AttnSrc { const u16* Kl; const u16* Vl; const u16* Kc; const u16* Vc; int nloc; int klo; int ldl; };

__device__ __forceinline__ void attn_load(const AttnSrc& a, int i, int lm, int slab, bf16x8 (&kf)[2][2], bf16x8 (&vf)[4]) {
  const bool loc = i < a.nloc;
  const u16* Kp = loc ? a.Kl : a.Kc;
  const u16* Vp = loc ? a.Vl : a.Vc;
  const int ldvt = loc ? a.ldl : 256;
  const int kb = loc ? a.klo + i * 32 : (i - a.nloc) * 32;
#pragma unroll
  for (int kt = 0; kt < 2; ++kt) {
    const u16* kr = Kp + (size_t)(kb + kt * 16 + lm) * 128 + slab * 8;
    kf[kt][0] = *(const bf16x8*)kr;
    kf[kt][1] = *(const bf16x8*)(kr + 32);
  }
#pragma unroll
  for (int dt = 0; dt < 4; ++dt) {
    const u16* vr = Vp + (size_t)(dt * 16 + lm) * ldvt + kb + slab * 4;
    u32x2 v0 = *(const u32x2*)vr, v1 = *(const u32x2*)(vr + 16);
    vf[dt] = as_bf16x8((u32x4){v0.x, v0.y, v1.x, v1.y});
  }
}

__device__ void attn_wave(KP p, int layer, int wtask) {
  const int lane = tidx() & 63;
  const int lm = lane & 15, slab = lane >> 4;
  int b, kvh, q0, tok0;
  AttnSrc a;
  if (wtask < 512) {
    b = wtask >> 7; kvh = (wtask >> 6) & 1; q0 = (wtask & 63) * 16; tok0 = T_CTX + b * 1024;
    int klo = q0 - 128; if (klo < 0) klo = 0; klo &= ~31;
    int khi = q0 + 15 + 128; if (khi > 1023) khi = 1023;
    a.klo = klo; a.nloc = (khi - klo) / 32 + 1; a.ldl = 1024;
    a.Kl = p.K16 + (size_t)tok0 * 128 + kvh * 64;
    a.Vl = p.VT + (size_t)T_CTX * 128 + (size_t)b * 128 * 1024 + (size_t)kvh * 64 * 1024;
    a.Kc = p.CK16 + (size_t)(b * DEPTH + layer) * 256 * 128 + kvh * 64;
    a.Vc = p.CVT16 + (size_t)(b * DEPTH + layer) * 128 * 256 + (size_t)kvh * 64 * 256;
  } else {
    int tt = wtask - 512;
    b = tt >> 5; kvh = (tt >> 4) & 1; q0 = (tt & 15) * 16; tok0 = b * 256;
    a.klo = 0; a.nloc = 0; a.ldl = 256;
    a.Kc = p.K16 + (size_t)tok0 * 128 + kvh * 64;
    a.Vc = p.VT + (size_t)b * 128 * 256 + (size_t)kvh * 64 * 256;
    a.Kl = a.Kc; a.Vl = a.Vc;
  }
  const int nblk = a.nloc + 8;
  bf16x8 qf[4][2];
#pragma unroll
  for (int hh = 0; hh < 4; ++hh) {
    const u16* qr = p.Q16 + (size_t)(tok0 + q0 + lm) * 512 + (kvh * 4 + hh) * 64 + slab * 8;
    qf[hh][0] = *(const bf16x8*)qr;
    qf[hh][1] = *(const bf16x8*)(qr + 32);
  }
  f32x4 o[4][4];
  float m[4], lsum[4];
#pragma unroll
  for (int hh = 0; hh < 4; ++hh) {
#pragma unroll
    for (int dt = 0; dt < 4; ++dt) o[hh][dt] = (f32x4){0.f, 0.f, 0.f, 0.f};
    m[hh] = p.sink[layer * 8 + kvh * 4 + hh];
    lsum[hh] = slab == 0 ? 1.f : 0.f;
  }
  const int qp = q0 + lm;
  bf16x8 kn[2][2], vn[4];
  attn_load(a, 0, lm, slab, kn, vn);
  for (int i = 0; i < nblk; ++i) {
    bf16x8 kc[2][2], vc[4];
#pragma unroll
    for (int kt = 0; kt < 2; ++kt) { kc[kt][0] = kn[kt][0]; kc[kt][1] = kn[kt][1]; }
#pragma unroll
    for (int dt = 0; dt < 4; ++dt) vc[dt] = vn[dt];
    if (i + 1 < nblk) attn_load(a, i + 1, lm, slab, kn, vn);
    const bool domask = i < a.nloc;
    const int kb = a.klo + i * 32;
#pragma unroll
    for (int hh = 0; hh < 4; ++hh) {
      f32x4 s[2];
#pragma unroll
      for (int kt = 0; kt < 2; ++kt) {
        f32x4 z = {0.f, 0.f, 0.f, 0.f};
        z = __builtin_amdgcn_mfma_f32_16x16x32_bf16(kc[kt][0], qf[hh][0], z, 0, 0, 0);
        z = __builtin_amdgcn_mfma_f32_16x16x32_bf16(kc[kt][1], qf[hh][1], z, 0, 0, 0);
        s[kt] = z * 0.125f;
      }
      if (domask) {
#pragma unroll
        for (int kt = 0; kt < 2; ++kt)
#pragma unroll
          for (int r = 0; r < 4; ++r) {
            int d = qp - (kb + kt * 16 + slab * 4 + r);
            if (d > 128 || d < -128) s[kt][r] = -1e30f;
          }
      }
      float mx = fmaxf(fmaxf(fmaxf(s[0][0], s[0][1]), fmaxf(s[0][2], s[0][3])), fmaxf(fmaxf(s[1][0], s[1][1]), fmaxf(s[1][2], s[1][3])));
      mx = fmaxf(mx, __shfl_xor(mx, 16, 64));
      mx = fmaxf(mx, __shfl_xor(mx, 32, 64));
      const float mn = fmaxf(m[hh], mx);
      const float alpha = __expf(m[hh] - mn);
      m[hh] = mn;
      float ps = 0.f;
#pragma unroll
      for (int kt = 0; kt < 2; ++kt)
#pragma unroll
        for (int r = 0; r < 4; ++r) {
          float e = __expf(s[kt][r] - mn);
          s[kt][r] = e;
          ps += e;
        }
      lsum[hh] = lsum[hh] * alpha + ps;
      const bf16x8 pfr = as_bf16x8((u32x4){pack_bf16(s[0][0], s[0][1]), pack_bf16(s[0][2], s[0][3]), pack_bf16(s[1][0], s[1][1]), pack_bf16(s[1][2], s[1][3])});
#pragma unroll
      for (int dt = 0; dt < 4; ++dt) {
        o[hh][dt] = o[hh][dt] * alpha;
        o[hh][dt] = __builtin_amdgcn_mfma_f32_16x16x32_bf16(vc[dt], pfr, o[hh][dt], 0, 0, 0);
      }
    }
  }
  u16* Y = p.Y4 + (size_t)3 * T_ALL * 512;
#pragma unroll
  for (int hh = 0; hh < 4; ++hh) {
    float l = lsum[hh];
    l += __shfl_xor(l, 16, 64);
    l += __shfl_xor(l, 32, 64);
    const float inv = 1.f / l;
#pragma unroll
    for (int dt = 0; dt < 4; ++dt)
      store_bf4(Y + (size_t)(tok0 + q0 + lm) * 512 + (kvh * 4 + hh) * 64 + dt * 16 + slab * 4, o[hh][dt] * inv);
  }
}

__device__ void phase_mix(KP p, int layer, char* smem) {
  const int NS5 = 320, NATT = 384, NFFT = 768, NCONV = 512;
  for (int task = bidx(); task < NS5 + NATT + NFFT + NCONV; task += gridDim.x) {
    if (task < NS5) s5_block(p, layer, task, smem);
    else if (task < NS5 + NATT) attn_wave(p, layer, (task - NS5) * 4 + (tidx() >> 6));
    else if (task < NS5 + NATT + NFFT) fft1_tile(p, task - NS5 - NATT, smem);
    else conv_job(p, layer, task - NS5 - NATT - NFFT, NCONV);
  }
  const size_t toff = (size_t)layer * 16384 * 1024;
  fp8_rows_job(p.peer_u + toff, p.U8 + 2 * toff, p.SCU + layer * 16384, 16384, 64);
  fp8_rows_job(p.peer_v + toff, p.U8 + 2 * toff + 1024, p.SCV + layer * 16384, 16384, 64);
}

__device__ void gates_job(KP p, int layer, char* smem) {
  EPI_SETUP
  for (int tile = bidx(); tile < 96 * 32; tile += gridDim.x) {
    const int mt = tile % 96, nt = tile / 96;
    f32x4 acc[4][4];
    gemm_mainloop_fp8(p.XM8 + (size_t)mt * 128 * DM, DM, p.WgT8 + ((size_t)layer * 4096 + nt * 128) * DM, DM, DM, acc, smem);
#pragma unroll
    for (int i = 0; i < 4; ++i)
#pragma unroll
      for (int j = 0; j < 4; ++j) {
        f32x4 v = acc[i][j] * (1.f / 64.f);
        u32 w = 0;
        w = __builtin_amdgcn_cvt_pk_u8_f32(sigmoid_f(v[0]) * 255.f, 0, w);
        w = __builtin_amdgcn_cvt_pk_u8_f32(sigmoid_f(v[1]) * 255.f, 1, w);
        w = __builtin_amdgcn_cvt_pk_u8_f32(sigmoid_f(v[2]) * 255.f, 2, w);
        w = __builtin_amdgcn_cvt_pk_u8_f32(sigmoid_f(v[3]) * 255.f, 3, w);
        *(u32*)((unsigned char*)p.G + (size_t)(mt * 128 + wm + i * 16 + lm) * 4096 + nt * 128 + wn + j * 16 + ln4) = w;
      }
  }
}

__device__ void phase_s5_combine(KP p, int layer) {
  const u16* YFW = p.MERGED;
  const u16* YBK = (const u16*)p.YBK;
  const float* dsk = p.ssm_d + layer * 512;
  const size_t n4 = (size_t)T_ALL * 128;
  for (size_t i = (size_t)bidx() * 256 + tidx(); i < n4; i += (size_t)gridDim.x * 256) {
    int c = (int)(i & 127) * 4;
    const u32x2 yf = *(const u32x2*)(YFW + i * 4), yb = *(const u32x2*)(YBK + i * 4);
    f32x4 v = (f32x4){bf_lo(yf.x) + bf_lo(yb.x), bf_hi(yf.x) + bf_hi(yb.x), bf_lo(yf.y) + bf_lo(yb.y), bf_hi(yf.y) + bf_hi(yb.y)}
              + *(const f32x4*)(dsk + c) * *(const f32x4*)(p.ZS + i * 4);
    v[0] = gelu_tanh(v[0]); v[1] = gelu_tanh(v[1]); v[2] = gelu_tanh(v[2]); v[3] = gelu_tanh(v[3]);
    store_bf4(p.YS + i * 4, v);
  }
}

__device__ void phase_fft2_glu(KP p, int layer, char* smem) {
  EPI_SETUP
  for (int task = bidx(); task < 128 + 256 + 384; task += gridDim.x) {
    f32x4 acc[4][4];
    if (task < 384) {
      int sg, mt, L, tok0;
      const u16 *A, *B;
      if (task < 128) { sg = task >> 3; mt = task & 7; L = 1024; tok0 = T_CTX + (sg >> 2) * 1024;
                        A = p.FL1024 + (size_t)mt * 128 * 2048; B = p.TTt + (size_t)T_CTX * 4 * 256 + (size_t)sg * 128 * 2048; }
      else { int tt = task - 128; sg = tt >> 1; mt = tt & 1; L = 256; tok0 = (sg >> 2) * 256;
             A = p.FL256 + (size_t)mt * 128 * 512; B = p.TTt + (size_t)sg * 128 * 512; }
      gemm_mainloop(A, 2 * L, B, 2 * L, 2 * L, acc, smem);
      const int g = sg & 3;
#pragma unroll
      for (int i = 0; i < 4; ++i)
#pragma unroll
        for (int j = 0; j < 4; ++j)
          store_bf4(p.Y4 + (size_t)(tok0 + mt * 128 + wm + i * 16 + lm) * 512 + g * 128 + wn + j * 16 + ln4, acc[i][j]);
    } else {
      int tt = task - 384;
      int mt = tt % 96, nt = tt / 96;
      gemm_mainloop(p.YS + (size_t)mt * 128 * 512, 512, p.WgluT + (size_t)layer * 512 * 512 + (size_t)nt * 128 * 512, 512, 512, acc, smem);
      u16* Y = p.Y4 + (size_t)2 * T_ALL * 512;
#pragma unroll
      for (int i = 0; i < 4; ++i)
#pragma unroll
        for (int j = 0; j < 4; ++j) {
          size_t a = (size_t)(mt * 128 + wm + i * 16 + lm) * 512 + nt * 128 + wn + j * 16 + ln4;
          u32x2 ys = *(const u32x2*)(p.YS + a);
          f32x4 v = acc[i][j];
          v[0] = bf_lo(ys.x) * sigmoid_f(v[0]);
          v[1] = bf_hi(ys.x) * sigmoid_f(v[1]);
          v[2] = bf_lo(ys.y) * sigmoid_f(v[2]);
          v[3] = bf_hi(ys.y) * sigmoid_f(v[3]);
          store_bf4(Y + a, v);
        }
    }
  }
}

__device__ void phase_branch(KP p, int layer, char* smem) {
  EPI_SETUP
  for (int tile = bidx(); tile < 96 * 8; tile += gridDim.x) {
    const int mt = tile % 96, nt = tile / 96;
    f32x4 tot[4][4];
#pragma unroll
    for (int i = 0; i < 4; ++i)
#pragma unroll
      for (int j = 0; j < 4; ++j) tot[i][j] = (f32x4){0.f, 0.f, 0.f, 0.f};
#pragma unroll 1
    for (int br = 0; br < 4; ++br) {
      f32x4 acc[4][4];
      gemm_mainloop(p.Y4 + (size_t)br * T_ALL * 512 + (size_t)mt * 128 * 512, 512,
                    p.WbrT + ((size_t)(layer * 4 + br) * 1024 + nt * 128) * 512, 512, 512, acc, smem);
      const unsigned char* gp = (const unsigned char*)p.G + (size_t)(mt * 128 + wm + lm) * 4096 + br * 1024 + nt * 128 + wn + ln4;
#pragma unroll
      for (int i = 0; i < 4; ++i)
#pragma unroll
        for (int j = 0; j < 4; ++j) {
          const u32 gq = *(const u32*)(gp + (size_t)(i * 16) * 4096 + j * 16);
          tot[i][j][0] += (float)(gq & 255u) * acc[i][j][0];
          tot[i][j][1] += (float)((gq >> 8) & 255u) * acc[i][j][1];
          tot[i][j][2] += (float)((gq >> 16) & 255u) * acc[i][j][2];
          tot[i][j][3] += (float)(gq >> 24) * acc[i][j][3];
        }
    }
#pragma unroll
    for (int i = 0; i < 4; ++i)
#pragma unroll
      for (int j = 0; j < 4; ++j)
        store_bf4(p.MERGED + (size_t)(mt * 128 + wm + i * 16 + lm) * 1024 + nt * 128 + wn + j * 16 + ln4, tot[i][j] * (1.f / 255.f));
  }
}

__device__ void phase_outproj(KP p, int layer, char* smem) {
  const int lane = tidx() & 63, wave = tidx() >> 6;
  const int wm = (wave >> 1) * 128, wn = (wave & 1) * 64;
  const int lm = lane & 15, ln4 = (lane >> 4) * 4;
  for (int tile = bidx(); tile < 48 * 8; tile += gridDim.x) {
    const int mt = tile % 48, nt = tile / 48;
    f32x4 acc[8][4];
    gemm_mainloop_big(p.MERGED + (size_t)mt * 256 * 1024, 1024, p.WoutT + ((size_t)layer * 1024 + nt * 128) * 1024, 1024, 1024, acc, smem);
    const float* g1 = p.MOD + ((size_t)layer * 5 + mod_group(mt * 256)) * 6144 + 2048;
#pragma unroll
    for (int i = 0; i < 8; ++i)
#pragma unroll
      for (int j = 0; j < 4; ++j) {
        int n = nt * 128 + wn + j * 16 + ln4;
        size_t a = (size_t)(mt * 256 + wm + i * 16 + lm) * 1024 + n;
        f32x4 x = *(const f32x4*)(p.X + a);
        f32x4 gg = *(const f32x4*)(g1 + n);
        *(f32x4*)(p.R1 + a) = x * ALPHA + gg * acc[i][j];
      }
  }
}

__device__ void phase_ln1(KP p, int layer) {
  const int lane = tidx() & 63;
  const int gw = bidx() * 4 + (tidx() >> 6), nw = gridDim.x * 4;
  const float* gam = p.ln1_g + layer * 1024;
  const float* bet = p.ln1_b + layer * 1024;
  for (int t = gw; t < T_ALL; t += nw) {
    f32x4 v[4];
    float s = 0.f;
#pragma unroll
    for (int i = 0; i < 4; ++i) {
      v[i] = *(const f32x4*)(p.R1 + (size_t)t * 1024 + i * 256 + lane * 4);
      s += v[i][0] + v[i][1] + v[i][2] + v[i][3];
    }
    float mu = wave_sum(s) * (1.f / 1024.f);
    float q = 0.f;
#pragma unroll
    for (int i = 0; i < 4; ++i) {
      v[i] = v[i] - mu;
      q += v[i][0] * v[i][0] + v[i][1] * v[i][1] + v[i][2] * v[i][2] + v[i][3] * v[i][3];
    }
    float rs = rsqrtf(wave_sum(q) * (1.f / 1024.f) + LN_EPS);
    const float* mod = p.MOD + ((size_t)layer * 5 + mod_group(t)) * 6144;
#pragma unroll
    for (int i = 0; i < 4; ++i) {
      int c = i * 256 + lane * 4;
      f32x4 y = v[i] * rs * *(const f32x4*)(gam + c) + *(const f32x4*)(bet + c);
      *(f32x4*)(p.X1 + (size_t)t * 1024 + c) = y;
      f32x4 sh = *(const f32x4*)(mod + 3072 + c), sc = *(const f32x4*)(mod + 4096 + c);
      store_bf4(p.XM2 + (size_t)t * 1024 + c, y * (sc + 1.f) + sh);
    }
  }
}

__device__ void phase_wq(KP p, int layer, char* smem) {
  const int lane = tidx() & 63, wave = tidx() >> 6;
  const int wm = (wave >> 1) * 128, wn = (wave & 1) * 64;
  const int lm = lane & 15, ln4 = (lane >> 4) * 4;
  for (int tile = bidx(); tile < 48 * 16; tile += gridDim.x) {
    const int mt = tile % 48, nt = tile / 48;
    f32x4 acc[8][4];
    gemm_mainloop_big(p.XM2 + (size_t)mt * 256 * 1024, 1024, p.WqT + ((size_t)layer * 2048 + nt * 128) * 1024, 1024, 1024, acc, smem);
#pragma unroll
    for (int i = 0; i < 8; ++i)
#pragma unroll
      for (int j = 0; j < 4; ++j)
        store_bf4(p.PQ + (size_t)(mt * 256 + wm + i * 16 + lm) * 2048 + nt * 128 + wn + j * 16 + ln4, acc[i][j]);
  }
}

__device__ void phase_scores(KP p, int layer, char* smem) {
  EPI_SETUP
  for (int tile = bidx(); tile < 96 * 16; tile += gridDim.x) {
    const int mt = tile % 96, hc = tile / 96;
    f32x4 acc[4][4];
    gemm_mainloop(p.SK16 + ((size_t)layer * 16 + hc) * 128 * 128, 128, p.PQ + (size_t)mt * 128 * 2048 + hc * 128, 2048, 128, acc, smem);
#pragma unroll
    for (int i = 0; i < 4; ++i)
#pragma unroll
      for (int j = 0; j < 4; ++j)
        *(f32x4*)(p.SC + ((size_t)hc * 128 + wm + i * 16 + lm) * T_ALL + mt * 128 + wn + j * 16 + ln4) = acc[i][j];
  }
}

__device__ __forceinline__ u32 ordkey(float f) {
  u32 u = __float_as_uint(f);
  return (u & 0x80000000u) ? ~u : (u | 0x80000000u);
}
__device__ __forceinline__ float unordkey(u32 k) {
  return __uint_as_float((k & 0x80000000u) ? (k ^ 0x80000000u) : ~k);
}
__device__ __forceinline__ void top16_128(const float* __restrict__ s, u32 (&top)[16]) {
#pragma unroll
  for (int j = 0; j < 16; ++j) top[j] = 0u;
  float nxt[16];
#pragma unroll
  for (int e = 0; e < 16; ++e) nxt[e] = s[(size_t)e * T_ALL];
  for (int c = 0; c < 8; ++c) {
    float cur[16];
#pragma unroll
    for (int e = 0; e < 16; ++e) cur[e] = nxt[e];
    if (c + 1 < 8) {
#pragma unroll
      for (int e = 0; e < 16; ++e) nxt[e] = s[(size_t)((c + 1) * 16 + e) * T_ALL];
    }
#pragma unroll
    for (int e = 0; e < 16; ++e) {
      u32 key = (ordkey(cur[e]) & ~0x7Fu) | (u32)(127 - (c * 16 + e));
#pragma unroll
      for (int j = 0; j < 16; ++j) {
        u32 hi = max(top[j], key);
        key = min(top[j], key);
        top[j] = hi;
      }
    }
  }
}

__device__ void phase_topk(KP p, int layer) {
  const int total = T_ALL * 8;
  for (int i = bidx() * 256 + tidx(); i < total; i += gridDim.x * 256) {
    const int h = i / T_ALL, t = i - h * T_ALL;
    const float* s1 = p.SC + ((size_t)(h * 2) * 128) * T_ALL + t;
    const float* s2 = s1 + (size_t)128 * T_ALL;
    u32 top1[16], top2[16];
    top16_128(s1, top1);
    top16_128(s2, top2);
    int i1[16], i2[16];
    float v1[16], v2[16];
#pragma unroll
    for (int a = 0; a < 16; ++a) {
      i1[a] = 127 - (int)(top1[a] & 127u);
      i2[a] = 127 - (int)(top2[a] & 127u);
      v1[a] = unordkey(top1[a] & ~0x7Fu);
      v2[a] = unordkey(top2[a] & ~0x7Fu);
    }
    u32 best[16];
#pragma unroll
    for (int j = 0; j < 16; ++j) best[j] = 0u;
#pragma unroll
    for (int a = 0; a < 16; ++a)
#pragma unroll
      for (int b = 0; b < 16; ++b) {
        if ((a + 1) * (b + 1) <= 16) {
          u32 key = (ordkey(v1[a] + v2[b]) & ~0xFFu) | (u32)(255 - (a * 16 + b));
#pragma unroll
          for (int j = 0; j < 16; ++j) {
            u32 hi = max(best[j], key);
            key = min(best[j], key);
            best[j] = hi;
          }
        }
      }
    float val[16];
    int idx[16];
    float mx = -3.0e38f;
#pragma unroll
    for (int k = 0; k < 16; ++k) {
      int pos = 255 - (int)(best[k] & 255u);
      int a = pos >> 4, b = pos & 15;
      int ia = 0, ib = 0;
      float va = 0.f, vb = 0.f;
#pragma unroll
      for (int j = 0; j < 16; ++j) {
        if (a == j) { ia = i1[j]; va = v1[j]; }
        if (b == j) { ib = i2[j]; vb = v2[j]; }
      }
      val[k] = va + vb;
      idx[k] = ia * 128 + ib;
      mx = fmaxf(mx, val[k]);
    }
    float sum = 0.f;
#pragma unroll
    for (int k = 0; k < 16; ++k) { val[k] = __expf(val[k] - mx); sum += val[k]; }
    float inv = 1.f / sum;
    int* po = p.PIDX + (size_t)t * 128 + h * 16;
    float* pg = p.PG + (size_t)t * 128 + h * 16;
#pragma unroll
    for (int k4 = 0; k4 < 4; ++k4) {
      *(i32x4*)(po + k4 * 4) = (i32x4){idx[k4 * 4], idx[k4 * 4 + 1], idx[k4 * 4 + 2], idx[k4 * 4 + 3]};
      *(f32x4*)(pg + k4 * 4) = (f32x4){val[k4 * 4] * inv, val[k4 * 4 + 1] * inv, val[k4 * 4 + 2] * inv, val[k4 * 4 + 3] * inv};
    }
  }
}

__device__ void phase_peer(KP p, int layer) {
  const int lane = tidx() & 63;
  const int gw = bidx() * 4 + (tidx() >> 6), nw = gridDim.x * 4;
  const unsigned char* U = p.U8 + (size_t)layer * 16384 * 2048;
  const unsigned char* V = U + 1024;
  const float* SU = p.SCU + layer * 16384;
  const float* SV = p.SCV + layer * 16384;
  const float* gam = p.ln2_g + layer * 1024;
  const float* bet = p.ln2_b + layer * 1024;
  for (int t = gw; t < T_ALL; t += nw) {
    f32x2_t x2[8];
    {
      const u32x4 xa = *(const u32x4*)(p.XM2 + (size_t)t * 1024 + lane * 16);
      const u32x4 xb = *(const u32x4*)(p.XM2 + (size_t)t * 1024 + lane * 16 + 8);
      x2[0] = (f32x2_t){bf_lo(xa.x), bf_hi(xa.x)}; x2[1] = (f32x2_t){bf_lo(xa.y), bf_hi(xa.y)};
      x2[2] = (f32x2_t){bf_lo(xa.z), bf_hi(xa.z)}; x2[3] = (f32x2_t){bf_lo(xa.w), bf_hi(xa.w)};
      x2[4] = (f32x2_t){bf_lo(xb.x), bf_hi(xb.x)}; x2[5] = (f32x2_t){bf_lo(xb.y), bf_hi(xb.y)};
      x2[6] = (f32x2_t){bf_lo(xb.z), bf_hi(xb.z)}; x2[7] = (f32x2_t){bf_lo(xb.w), bf_hi(xb.w)};
    }
    const int il0 = p.PIDX[(size_t)t * 128 + lane], il1 = p.PIDX[(size_t)t * 128 + 64 + lane];
    const float su0 = SU[il0], su1 = SU[il1];
    const float gv0 = p.PG[(size_t)t * 128 + lane] * SV[il0], gv1 = p.PG[(size_t)t * 128 + 64 + lane] * SV[il1];
    f32x2_t out[8];
#pragma unroll
    for (int k = 0; k < 8; ++k) out[k] = (f32x2_t){0.f, 0.f};
    for (int e0 = 0; e0 < 128; e0 += 8) {
      const int ilx = e0 < 64 ? il0 : il1;
      const float sux = e0 < 64 ? su0 : su1, gvx = e0 < 64 ? gv0 : gv1;
      u32x4 uq[8], vq[8];
      float cv[8];
#pragma unroll
      for (int q = 0; q < 8; ++q) {
        const int e = (e0 + q) & 63;
        const int id = __builtin_amdgcn_readlane(ilx, e);
        cv[q] = __builtin_bit_cast(float, __builtin_amdgcn_readlane(__builtin_bit_cast(int, gvx), e));
        uq[q] = *(const u32x4*)(U + (size_t)id * 2048 + lane * 16);
        vq[q] = *(const u32x4*)(V + (size_t)id * 2048 + lane * 16);
      }
      float d8[8];
#pragma unroll
      for (int q = 0; q < 8; ++q) {
        f32x2_t acc = (f32x2_t){0.f, 0.f};
#pragma unroll
        for (int w = 0; w < 4; ++w) {
          acc += __builtin_amdgcn_cvt_pk_f32_fp8((int)uq[q][w], false) * x2[w * 2];
          acc += __builtin_amdgcn_cvt_pk_f32_fp8((int)uq[q][w], true) * x2[w * 2 + 1];
        }
        d8[q] = acc.x + acc.y;
      }
      const bool hi32 = (lane & 32) != 0, hi16 = (lane & 16) != 0, hi8 = (lane & 8) != 0;
      float d4[4], d2[2], d1;
#pragma unroll
      for (int k = 0; k < 4; ++k) {
        const float keep = hi32 ? d8[k + 4] : d8[k], send = hi32 ? d8[k] : d8[k + 4];
        d4[k] = keep + __shfl_xor(send, 32, 64);
      }
#pragma unroll
      for (int k = 0; k < 2; ++k) {
        const float keep = hi16 ? d4[k + 2] : d4[k], send = hi16 ? d4[k] : d4[k + 2];
        d2[k] = keep + __shfl_xor(send, 16, 64);
      }
      {
        const float keep = hi8 ? d2[1] : d2[0], send = hi8 ? d2[0] : d2[1];
        d1 = keep + __shfl_xor(send, 8, 64);
      }
      d1 += __shfl_xor(d1, 4, 64);
      d1 += __shfl_xor(d1, 2, 64);
      d1 += __shfl_xor(d1, 1, 64);
#pragma unroll
      for (int q = 0; q < 8; ++q) {
        const int e = (e0 + q) & 63;
        const float dq = __builtin_bit_cast(float, __builtin_amdgcn_readlane(__builtin_bit_cast(int, d1), q * 8));
        const float cu = __builtin_bit_cast(float, __builtin_amdgcn_readlane(__builtin_bit_cast(int, sux), e));
        const float cf = cv[q] * gelu_tanh(dq * cu);
        const f32x2_t cf2 = (f32x2_t){cf, cf};
#pragma unroll
        for (int w = 0; w < 4; ++w) {
          out[w * 2] += cf2 * __builtin_amdgcn_cvt_pk_f32_fp8((int)vq[q][w], false);
          out[w * 2 + 1] += cf2 * __builtin_amdgcn_cvt_pk_f32_fp8((int)vq[q][w], true);
        }
      }
    }
    const float* mod = p.MOD + ((size_t)layer * 5 + mod_group(t)) * 6144;
    float r[16];
    float s = 0.f;
#pragma unroll
    for (int q = 0; q < 4; ++q) {
      int c = lane * 16 + q * 4;
      f32x4 x1 = *(const f32x4*)(p.X1 + (size_t)t * 1024 + c);
      f32x4 g2 = *(const f32x4*)(mod + 5120 + c);
      float o4[4] = {out[q * 2].x, out[q * 2].y, out[q * 2 + 1].x, out[q * 2 + 1].y};
#pragma unroll
      for (int k = 0; k < 4; ++k) {
        float v = ALPHA * x1[k] + g2[k] * o4[k];
        r[q * 4 + k] = v;
        s += v;
      }
    }
    float mu = wave_sum(s) * (1.f / 1024.f);
    float qq = 0.f;
#pragma unroll
    for (int k = 0; k < 16; ++k) { r[k] -= mu; qq += r[k] * r[k]; }
    float rs = rsqrtf(wave_sum(qq) * (1.f / 1024.f) + LN_EPS);
    const bool last = layer == DEPTH - 1;
    float* xo = last ? p.out : p.X;
    const float* modn = p.MOD + ((size_t)(last ? layer : layer + 1) * 5 + mod_group(t)) * 6144;
#pragma unroll
    for (int q = 0; q < 4; ++q) {
      int c = lane * 16 + q * 4;
      f32x4 gg = *(const f32x4*)(gam + c), bb = *(const f32x4*)(bet + c);
      f32x4 y;
#pragma unroll
      for (int k = 0; k < 4; ++k) y[k] = r[q * 4 + k] * rs * gg[k] + bb[k];
      *(f32x4*)(xo + (size_t)t * 1024 + c) = y;
      if (!last) {
        f32x4 sh = *(const f32x4*)(modn + c), sc = *(const f32x4*)(modn + 1024 + c);
        { const f32x4 xm = y * (sc + 1.f) + sh;
          store_bf4(p.XM + (size_t)t * 1024 + c, xm);
          int w8 = 0;
          w8 = __builtin_amdgcn_cvt_pk_fp8_f32(xm[0], xm[1], w8, false);
          w8 = __builtin_amdgcn_cvt_pk_fp8_f32(xm[2], xm[3], w8, true);
          *(int*)(p.XM8 + (size_t)t * 1024 + c) = w8; }
      }
    }
  }
}

#define XB_TMO      128
#define XB_XCNT(j)  (256  + 64 * (j))
#define XB_XSUB(j)  (1280 + 64 * (j))
#define XB_XGEN(j)  (2304 + 64 * (j))
#define XB_TOP      3328
#define XB_TOPGEN   3392
#define XCD_BAR_WORDS 3456
#define XB_SPIN_CAP (1u << 18)
#define LAS __attribute__((address_space(3)))

__device__ __forceinline__ unsigned xb_ld(unsigned* p)              { return __hip_atomic_load(p, __ATOMIC_RELAXED, __HIP_MEMORY_SCOPE_AGENT); }
__device__ __forceinline__ unsigned xb_add(unsigned* p, unsigned v) { return __hip_atomic_fetch_add(p, v, __ATOMIC_RELAXED, __HIP_MEMORY_SCOPE_AGENT); }
__device__ __forceinline__ unsigned xb_xcc_id() { return (unsigned)__builtin_amdgcn_s_getreg((3 << 11) | 20) & 0xFu; }
#define XB_SPIN(cond, bar) do { unsigned _sp = 0; while (cond) { __builtin_amdgcn_s_sleep(1); \
    if ((++_sp & 255u) == 0u) { if (xb_ld(&(bar)[XB_TMO])) break; if (_sp > XB_SPIN_CAP) { atomicAdd(&(bar)[XB_TMO], 1u); break; } } } } while (0)

struct XcdBarrier {
    unsigned* bar; unsigned x;
    volatile LAS unsigned* st;
};

__device__ __forceinline__ XcdBarrier xcd_barrier_post(unsigned* bar, volatile LAS unsigned* st) {
    XcdBarrier b; b.bar = bar; b.x = xb_xcc_id(); b.st = st;
    if (threadIdx.x == 0) (void)xb_add(&bar[XB_XCNT(b.x)], 1u);
    return b;
}
__device__ __forceinline__ void xcd_barrier_complete(unsigned* bar, unsigned x, unsigned& nloc, unsigned& nx) {
    const unsigned G = gridDim.x * gridDim.y * gridDim.z;
    unsigned sum, cnt, mine, sp = 0u;
    for (;;) {
        sum = 0u; cnt = 0u; mine = 0u;
#pragma unroll
        for (unsigned j = 0; j < 16; ++j) { const unsigned c = xb_ld(&bar[XB_XCNT(j)]); sum += c; cnt += (c > 0u) ? 1u : 0u; mine = (j == x) ? c : mine; }
        if (sum == G) break;
        __builtin_amdgcn_s_sleep(1);
        if ((++sp & 255u) == 0u) { if (xb_ld(&bar[XB_TMO])) break; if (sp > XB_SPIN_CAP) { atomicAdd(&bar[XB_TMO], 1u); break; } }
    }
    nloc = mine > 0u ? mine : 1u; nx = cnt > 0u ? cnt : 1u;
}

__device__ __forceinline__ void xcd_barrier(const XcdBarrier& b) {
    asm volatile("s_waitcnt vmcnt(0)" ::: "memory");
    __syncthreads();
    if (threadIdx.x == 0) {
        unsigned* bar = b.bar;
        __builtin_amdgcn_s_waitcnt(0);
        unsigned nloc = b.st[0], nx = b.st[1];
        if (nloc == 0u) { xcd_barrier_complete(bar, b.x, nloc, nx); b.st[0] = nloc; b.st[1] = nx; }
        const unsigned old = xb_add(&bar[XB_XSUB(b.x)], 1u);
        const unsigned gen = old / nloc;
        if (old + 1u == (gen + 1u) * nloc) {
            __builtin_amdgcn_fence(__ATOMIC_RELEASE, "agent");
            asm volatile("s_waitcnt vmcnt(0)" ::: "memory");
            const unsigned og = xb_add(&bar[XB_TOP], 1u);
            const unsigned tg = og / nx;
            if (og + 1u == (tg + 1u) * nx) xb_add(&bar[XB_TOPGEN], 1u);
            else XB_SPIN(xb_ld(&bar[XB_TOPGEN]) == tg, bar);
            __builtin_amdgcn_fence(__ATOMIC_ACQUIRE, "agent");
            xb_add(&bar[XB_XGEN(b.x)], 1u);
            asm volatile("s_waitcnt vmcnt(0)" ::: "memory");
        } else {
            XB_SPIN(xb_ld(&bar[XB_XGEN(b.x)]) == gen, bar);
            __builtin_amdgcn_fence(__ATOMIC_ACQUIRE, "agent");
            asm volatile("s_waitcnt vmcnt(0)" ::: "memory");
        }
    }
    __syncthreads();
}


#define SMEM_BYTES (4 * (128 * BU_STR * 4 + 16 * H_STR * 4))
#define PH_PER_LAYER 11
#define N_PHASES (2 + DEPTH * PH_PER_LAYER)

__device__ __forceinline__ void run_phase(KP p, int ph, char* smem) {
  if (ph == 0) { prologue0(p, smem); return; }
  if (ph == 1) { prologue1(p); return; }
  const int layer = (ph - 2) / PH_PER_LAYER, s = (ph - 2) % PH_PER_LAYER;
  switch (s) {
    case 0: phase_inproj(p, layer, smem); break;
    case 1: phase_mix(p, layer, smem); break;
    case 2: phase_s5_combine(p, layer); gates_job(p, layer, smem); break;
    case 3: phase_fft2_glu(p, layer, smem); break;
    case 4: phase_branch(p, layer, smem); break;
    case 5: phase_outproj(p, layer, smem); break;
    case 6: phase_ln1(p, layer); break;
    case 7: phase_wq(p, layer, smem); break;
    case 8: phase_scores(p, layer, smem); break;
    case 9: phase_topk(p, layer); break;
    default: phase_peer(p, layer); break;
  }
}

__global__ void __launch_bounds__(256, 2) mega_kernel(Params p) {
  __shared__ __attribute__((aligned(16))) char smem[SMEM_BYTES];
  __shared__ uint4 xb_words;
  cg::grid_group grid = cg::this_grid();
  if (threadIdx.x == 0) xb_words = make_uint4(0u, 0u, 0u, 0u);
  __syncthreads();
  XcdBarrier xb = xcd_barrier_post(p.bar, (volatile LAS unsigned*)&xb_words);
  grid.sync();
  for (int ph = 0; ph < N_PHASES; ++ph) {
    int reps = 1;
#ifdef PROBE_REPEAT
    if (ph >= 2 && ((PROBE_REPEAT >> ((ph - 2) % PH_PER_LAYER)) & 1)) reps = 2;
    if (ph == 0 && (PROBE_REPEAT & 0x10000)) reps = 2;
#endif
    for (int r = 0; r < reps; ++r) {
      KParams* pp = (KParams*)__builtin_amdgcn_kernarg_segment_ptr();
      asm volatile("" : "+s"(pp));
      run_phase(*pp, ph, smem);
      if (ph + 1 < N_PHASES) xcd_barrier(xb);
#ifdef PROBE_SYNCS
      if (ph >= 2 && ph + 1 < N_PHASES) { xcd_barrier(xb); xcd_barrier(xb); }
#endif
    }
  }
}

#if MULTI_LAUNCH
__global__ void __launch_bounds__(256, 2) phase_kernel(Params p, int ph) {
  __shared__ __attribute__((aligned(16))) char smem[SMEM_BYTES];
  run_phase(p, ph, smem);
}

__global__ void dump_kernel(Params p, int which) {
  size_t n = (size_t)T_ALL * 1024;
  for (size_t i = (size_t)blockIdx.x * 256 + threadIdx.x; i < n; i += (size_t)gridDim.x * 256) {
    float v = 0.f;
    if (which == 0) v = i < (size_t)T_ALL * 512 ? bf_lo((u32)p.Y4[i]) : 0.f;
    else if (which == 9) v = i < (size_t)T_ALL * 512 ? bf_lo((u32)p.Y4[(size_t)T_ALL * 512 + i]) : 0.f;
    else if (which == 10) v = bf_lo((u32)p.TTt[i]);
    else if (which == 1) v = bf_lo((u32)p.Y4[(size_t)2 * T_ALL * 512 + i]);
    else if (which == 2) v = bf_lo((u32)p.MERGED[i]);
    else if (which == 3) v = p.R1[i];
    else if (which == 4) v = p.X1[i];
    else if (which == 5) v = bf_lo((u32)p.PQ[i]);
    else if (which == 6) v = p.SC[i];
    else if (which == 7) v = i < (size_t)T_ALL * 128 ? (float)p.PIDX[i] : (i < (size_t)T_ALL * 256 ? p.PG[i - (size_t)T_ALL * 128] : 0.f);
    else v = p.X[i];
    p.out[i] = v;
  }
}

#endif

extern "C" void kernel_launch(void* const* d_in, const int* in_sizes, int n_in, void* d_out, int out_size, void* d_ws,
                              size_t ws_size, hipStream_t stream) {
  Params p{};
  const float** ins = (const float**)&p;
  for (int i = 0; i < 32; ++i) ins[i] = (const float*)d_in[i];
  p.out = (float*)d_out;
  char* w = (char*)d_ws;
  size_t off = 0;
  auto take = [&](size_t bytes) { char* r = w + off; off += (bytes + 255) & ~(size_t)255; return r; };
  p.U16 = (u16*)take((size_t)DEPTH * 16384 * 1024);
  p.V16 = (u16*)take((size_t)DEPTH * 16384 * 1024);
  p.bar = (unsigned*)take((size_t)XCD_BAR_WORDS * 4);
  p.U8 = (unsigned char*)p.U16;
  p.V8 = (unsigned char*)p.V16;
  p.XM8 = (unsigned char*)take((size_t)T_ALL * 1024);
  p.WgT8 = (unsigned char*)take((size_t)DEPTH * 4096 * 1024);
  p.SCU = (float*)take((size_t)DEPTH * 16384 * 4);
  p.SCV = (float*)take((size_t)DEPTH * 16384 * 4);
  p.WinT = (u16*)take((size_t)DEPTH * NCOL * 1024 * 2);
  p.WbrT = (u16*)take((size_t)DEPTH * 4 * 1024 * 512 * 2);
  p.WoutT = (u16*)take((size_t)DEPTH * 1024 * 1024 * 2);
  p.WqT = (u16*)take((size_t)DEPTH * 2048 * 1024 * 2);
  p.WgluT = (u16*)take((size_t)DEPTH * 512 * 512 * 2);
  p.SK16 = (u16*)take((size_t)DEPTH * 16 * 128 * 128 * 2);
  p.FC = (u16*)take((size_t)256 * 128 * 2);
  p.FL256 = (u16*)take((size_t)256 * 512 * 2);
  p.FL1024 = (u16*)take((size_t)1024 * 2048 * 2);
  p.CK16 = (u16*)take((size_t)16 * 256 * 128 * 2);
  p.CVT16 = (u16*)take((size_t)16 * 256 * 128 * 2);
  p.MOD = (float*)take((size_t)DEPTH * 5 * 6144 * 4);
  p.ROPE = (float*)take((size_t)2048 * 4);
  p.X = (float*)take((size_t)T_ALL * 1024 * 4);
  p.X1 = (float*)take((size_t)T_ALL * 1024 * 4);
  p.XM = (u16*)take((size_t)T_ALL * 1024 * 2);
  p.XM2 = (u16*)take((size_t)T_ALL * 1024 * 2);
  p.PIDX = (int*)take((size_t)T_ALL * 128 * 4);
  p.PG = (float*)take((size_t)T_ALL * 128 * 4);
  p.ZF = (u16*)take((size_t)T_ALL * 512 * 2);
  p.ZCV = (u16*)take((size_t)T_ALL * 1536 * 2);
  p.ZS = (float*)take((size_t)T_ALL * 512 * 4);
  p.Q16 = (u16*)take((size_t)T_ALL * 512 * 2);
  p.K16 = (u16*)take((size_t)T_ALL * 128 * 2);
  p.VT = (u16*)take((size_t)T_ALL * 128 * 2);
  p.TTt = (u16*)take((size_t)T_ALL * 4 * 256 * 2);
  p.Y4 = (u16*)take((size_t)4 * T_ALL * 512 * 2);
  p.YS = (u16*)take((size_t)T_ALL * 512 * 2);
  p.YBK = (float*)take((size_t)T_ALL * 512 * 4);
  p.MERGED = (u16*)take((size_t)T_ALL * 1024 * 2);
  p.G = (u16*)take((size_t)T_ALL * 4096 * 2);
  p.R1 = (float*)p.G;
  p.PQ = (u16*)((char*)p.G + (size_t)T_ALL * 1024 * 4);
  p.SC = (float*)p.ZF;
  if (off > ws_size) { fprintf(stderr, "workspace too small: need %zu have %zu\n", off, ws_size); return; }
#if MULTI_LAUNCH
#ifndef DEBUG_NPH
#define DEBUG_NPH N_PHASES
#endif
  for (int ph = 0; ph < DEBUG_NPH; ++ph) phase_kernel<<<dim3(1024), dim3(256), 0, stream>>>(p, ph);
#ifdef DEBUG_DUMP
  dump_kernel<<<dim3(1024), dim3(256), 0, stream>>>(p, DEBUG_DUMP);
#endif
#else
  static int grid_blocks = 0;
  if (!grid_blocks) {
    int dev = 0, cus = 0, per_cu = 0;
    hipGetDevice(&dev);
    hipDeviceGetAttribute(&cus, hipDeviceAttributeMultiprocessorCount, dev);
    hipOccupancyMaxActiveBlocksPerMultiprocessor(&per_cu, mega_kernel, 256, 0);
    if (per_cu > 2) per_cu = 2;
    grid_blocks = cus * per_cu;
  }
  hipMemsetAsync(p.bar, 0, (size_t)XCD_BAR_WORDS * 4, stream);
  void* args[] = {&p};
  hipError_t e = hipLaunchCooperativeKernel((void*)mega_kernel, dim3(grid_blocks), dim3(256), args, 0, stream);
  if (e != hipSuccess) fprintf(stderr, "cooperative launch failed: %s (grid %d)\n", hipGetErrorString(e), grid_blocks);
#endif
}
```

```cpp
#include <hip/hip_runtime.h>
#include <hip/hip_cooperative_groups.h>
#include <cstdio>
#include <cstdint>
namespace cg = cooperative_groups;

typedef unsigned short u16;
typedef unsigned int u32;
typedef __attribute__((ext_vector_type(8))) short bf16x8;
typedef __attribute__((ext_vector_type(4))) float f32x4;
typedef __attribute__((ext_vector_type(4))) unsigned int u32x4;
typedef __attribute__((ext_vector_type(2))) unsigned int u32x2;
typedef __attribute__((ext_vector_type(4))) int i32x4;
typedef __attribute__((ext_vector_type(2))) __bf16 bf16x2;


#ifndef MULTI_LAUNCH
#define MULTI_LAUNCH 0
#endif

#define T_CTX 8192
#define T_LAT 4096
#define T_ALL 12288
#define DM 1024
#define NCOL 7424
#define DEPTH 4
#define ALPHA 1.6817928305074290f
#define LN_EPS 1e-5f

struct Params {
  const float *x_prompt, *x_sample, *cache_k, *cache_v, *st_re, *st_im, *c, *c_ctx, *w_ada, *b_ada, *w_in, *conv_w,
      *lam_re, *lam_im, *log_step, *b_re, *b_im, *c_re, *c_im, *ssm_d, *w_glu, *sink, *w_branch, *w_out,
      *ln1_g, *ln1_b, *ln2_g, *ln2_b, *peer_wq, *subkeys, *peer_u, *peer_v;
  float* out;
  u16 *U16, *V16, *WinT, *WbrT, *WoutT, *WqT, *WgluT, *SK16, *FC, *FL256, *FL1024, *CK16, *CVT16;
  float *MOD, *ROPE;
  float *X, *X1;
  u16 *XM, *XM2;
  u16 *ZF, *ZCV;
  float* ZS;
  u16 *Q16, *K16, *VT, *G, *TTt, *Y4, *YS, *MERGED;
  float *YBK, *R1;
  u16* PQ;
  float* SC;
  int* PIDX;
  float* PG;
  unsigned char *U8, *V8;
  unsigned char *XM8, *WgT8;
  float *SCU, *SCV;
  unsigned* bar;
};
typedef const __attribute__((address_space(4))) Params KParams;
#define KP KParams&


__device__ __forceinline__ int tidx() { int t = threadIdx.x; asm volatile("" : "+v"(t)); return t; }
__device__ __forceinline__ int wave_id() { return __builtin_amdgcn_readfirstlane(tidx() >> 6); }
__device__ __forceinline__ int bidx() { int b = blockIdx.x; asm volatile("" : "+s"(b)); return b; }
typedef __attribute__((ext_vector_type(2))) float f32x2;
__device__ __forceinline__ u32 pack_bf16(float lo, float hi) {
  bf16x2 v = __builtin_convertvector((f32x2){lo, hi}, bf16x2);
  return __builtin_bit_cast(u32, v);
}
__device__ __forceinline__ float bf_lo(u32 u) { return __uint_as_float(u << 16); }
__device__ __forceinline__ float bf_hi(u32 u) { return __uint_as_float(u & 0xffff0000u); }
__device__ __forceinline__ float sigmoid_f(float x) { return __builtin_amdgcn_rcpf(1.f + __expf(-x)); }
__device__ __forceinline__ float gelu_tanh(float x) {
  float y = 0.7978845608028654f * (x + 0.044715f * x * x * x);
  return x * sigmoid_f(2.f * y);
}
__device__ __forceinline__ float dot2bf(u32 a, u32 b, float acc) {
  return __builtin_amdgcn_fdot2_f32_bf16(__builtin_bit_cast(bf16x2, a), __builtin_bit_cast(bf16x2, b), acc, false);
}
__device__ __forceinline__ bf16x8 as_bf16x8(u32x4 v) { return __builtin_bit_cast(bf16x8, v); }
__device__ __forceinline__ float wave_sum(float v) {
#pragma unroll
  for (int o = 32; o >= 1; o >>= 1) v += __shfl_xor(v, o, 64);
  return v;
}
__device__ __forceinline__ int mod_group(int t) { return t < T_CTX ? 0 : 1 + ((t - T_CTX) >> 10); }

#define LSTR 72
template <int NJ>
__device__ __forceinline__ void gemm_mainloop_t(const u16* __restrict__ A, size_t lda, const u16* __restrict__ Bt, size_t ldb,
                                                int K, f32x4 (&acc)[4][NJ], char* smem) {
  u16* sA = (u16*)smem;
  u16* sB = sA + 128 * LSTR;
  const int tid = tidx(), lane = tid & 63, wave = tid >> 6;
  const int wm = (wave >> 1) * 64, wn = (wave & 1) * (16 * NJ);
#pragma unroll
  for (int i = 0; i < 4; ++i)
#pragma unroll
    for (int j = 0; j < NJ; ++j) acc[i][j] = (f32x4){0.f, 0.f, 0.f, 0.f};
  u32x4 ra[4], rb[NJ];
  const int lr = tid >> 3, lc = (tid & 7) * 8;
  const u16* ap = A + (size_t)lr * lda + lc;
  const u16* bp = Bt + (size_t)lr * ldb + lc;
#pragma unroll
  for (int i = 0; i < 4; ++i) ra[i] = *(const u32x4*)(ap + (size_t)(i * 32) * lda);
#pragma unroll
  for (int i = 0; i < NJ; ++i) rb[i] = *(const u32x4*)(bp + (size_t)(i * 32) * ldb);
  for (int k0 = 0; k0 < K; k0 += 64) {
    __syncthreads();
#pragma unroll
    for (int i = 0; i < 4; ++i) *(u32x4*)(sA + (lr + i * 32) * LSTR + lc) = ra[i];
#pragma unroll
    for (int i = 0; i < NJ; ++i) *(u32x4*)(sB + (lr + i * 32) * LSTR + lc) = rb[i];
    __syncthreads();
    if (k0 + 64 < K) {
#pragma unroll
      for (int i = 0; i < 4; ++i) ra[i] = *(const u32x4*)(ap + (size_t)(i * 32) * lda + k0 + 64);
#pragma unroll
      for (int i = 0; i < NJ; ++i) rb[i] = *(const u32x4*)(bp + (size_t)(i * 32) * ldb + k0 + 64);
    }
    __builtin_amdgcn_s_setprio(1);
#pragma unroll
    for (int ks = 0; ks < 2; ++ks) {
      bf16x8 af[4], bfr[NJ];
      const int koff = ks * 32 + (lane >> 4) * 8;
#pragma unroll
      for (int i = 0; i < 4; ++i) af[i] = *(const bf16x8*)(sA + (wm + i * 16 + (lane & 15)) * LSTR + koff);
#pragma unroll
      for (int j = 0; j < NJ; ++j) bfr[j] = *(const bf16x8*)(sB + (wn + j * 16 + (lane & 15)) * LSTR + koff);
#pragma unroll
      for (int i = 0; i < 4; ++i)
#pragma unroll
        for (int j = 0; j < NJ; ++j)
          acc[i][j] = __builtin_amdgcn_mfma_f32_16x16x32_bf16(bfr[j], af[i], acc[i][j], 0, 0, 0);
    }
    __builtin_amdgcn_s_setprio(0);
  }
  __syncthreads();
}
__device__ __forceinline__ void gemm_mainloop(const u16* __restrict__ A, size_t lda, const u16* __restrict__ Bt, size_t ldb,
                                              int K, f32x4 (&acc)[4][4], char* smem) {
  gemm_mainloop_t<4>(A, lda, Bt, ldb, K, acc, smem);
}

__device__ __forceinline__ void gemm_mainloop_big(const u16* __restrict__ A, size_t lda, const u16* __restrict__ Bt, size_t ldb,
                                                  int K, f32x4 (&acc)[8][4], char* smem) {
  u16* sA = (u16*)smem;
  u16* sB = sA + 256 * LSTR;
  const int tid = tidx(), lane = tid & 63, wave = tid >> 6;
  const int wm = (wave >> 1) * 128, wn = (wave & 1) * 64;
#pragma unroll
  for (int i = 0; i < 8; ++i)
#pragma unroll
    for (int j = 0; j < 4; ++j) acc[i][j] = (f32x4){0.f, 0.f, 0.f, 0.f};
  u32x4 ra[8], rb[4];
  const int lr = tid >> 3, lc = (tid & 7) * 8;
  const u16* ap = A + (size_t)lr * lda + lc;
  const u16* bp = Bt + (size_t)lr * ldb + lc;
#pragma unroll
  for (int i = 0; i < 8; ++i) ra[i] = *(const u32x4*)(ap + (size_t)(i * 32) * lda);
#pragma unroll
  for (int i = 0; i < 4; ++i) rb[i] = *(const u32x4*)(bp + (size_t)(i * 32) * ldb);
  for (int k0 = 0; k0 < K; k0 += 64) {
    __syncthreads();
#pragma unroll
    for (int i = 0; i < 8; ++i) *(u32x4*)(sA + (lr + i * 32) * LSTR + lc) = ra[i];
#pragma unroll
    for (int i = 0; i < 4; ++i) *(u32x4*)(sB + (lr + i * 32) * LSTR + lc) = rb[i];
    __syncthreads();
    if (k0 + 64 < K) {
#pragma unroll
      for (int i = 0; i < 8; ++i) ra[i] = *(const u32x4*)(ap + (size_t)(i * 32) * lda + k0 + 64);
#pragma unroll
      for (int i = 0; i < 4; ++i) rb[i] = *(const u32x4*)(bp + (size_t)(i * 32) * ldb + k0 + 64);
    }
    __builtin_amdgcn_s_setprio(1);
#pragma unroll
    for (int ks = 0; ks < 2; ++ks) {
      const int koff = ks * 32 + (lane >> 4) * 8;
      bf16x8 bfr[4];
#pragma unroll
      for (int j = 0; j < 4; ++j) bfr[j] = *(const bf16x8*)(sB + (wn + j * 16 + (lane & 15)) * LSTR + koff);
#pragma unroll
      for (int i = 0; i < 8; ++i) {
        const bf16x8 af = *(const bf16x8*)(sA + (wm + i * 16 + (lane & 15)) * LSTR + koff);
#pragma unroll
        for (int j = 0; j < 4; ++j)
          acc[i][j] = __builtin_amdgcn_mfma_f32_16x16x32_bf16(bfr[j], af, acc[i][j], 0, 0, 0);
      }
    }
    __builtin_amdgcn_s_setprio(0);
  }
  __syncthreads();
}

__device__ __forceinline__ void gemm_mainloop_fp8(const unsigned char* __restrict__ A, size_t lda, const unsigned char* __restrict__ Bt, size_t ldb,
                                                  int K, f32x4 (&acc)[4][4], char* smem) {
  unsigned char* sA = (unsigned char*)smem;
  unsigned char* sB = sA + 128 * 144;
  const int tid = tidx(), lane = tid & 63, wave = tid >> 6;
  const int wm = (wave >> 1) * 64, wn = (wave & 1) * 64;
#pragma unroll
  for (int i = 0; i < 4; ++i)
#pragma unroll
    for (int j = 0; j < 4; ++j) acc[i][j] = (f32x4){0.f, 0.f, 0.f, 0.f};
  u32x4 ra[4], rb[4];
  const int lr = tid >> 3, lc = (tid & 7) * 16;
  const unsigned char* ap = A + (size_t)lr * lda + lc;
  const unsigned char* bp = Bt + (size_t)lr * ldb + lc;
#pragma unroll
  for (int i = 0; i < 4; ++i) {
    ra[i] = *(const u32x4*)(ap + (size_t)(i * 32) * lda);
    rb[i] = *(const u32x4*)(bp + (size_t)(i * 32) * ldb);
  }
  for (int k0 = 0; k0 < K; k0 += 128) {
    __syncthreads();
#pragma unroll
    for (int i = 0; i < 4; ++i) {
      *(u32x4*)(sA + (lr + i * 32) * 144 + lc) = ra[i];
      *(u32x4*)(sB + (lr + i * 32) * 144 + lc) = rb[i];
    }
    __syncthreads();
    if (k0 + 128 < K) {
#pragma unroll
      for (int i = 0; i < 4; ++i) {
        ra[i] = *(const u32x4*)(ap + (size_t)(i * 32) * lda + k0 + 128);
        rb[i] = *(const u32x4*)(bp + (size_t)(i * 32) * ldb + k0 + 128);
      }
    }
    __builtin_amdgcn_s_setprio(1);
#pragma unroll
    for (int ks = 0; ks < 4; ++ks) {
      const int koff = ks * 32 + (lane >> 4) * 8;
      long bfr[4];
#pragma unroll
      for (int j = 0; j < 4; ++j) bfr[j] = *(const long*)(sB + (wn + j * 16 + (lane & 15)) * 144 + koff);
#pragma unroll
      for (int i = 0; i < 4; ++i) {
        const long af = *(const long*)(sA + (wm + i * 16 + (lane & 15)) * 144 + koff);
#pragma unroll
        for (int j = 0; j < 4; ++j)
          acc[i][j] = __builtin_amdgcn_mfma_f32_16x16x32_fp8_fp8(bfr[j], af, acc[i][j], 0, 0, 0);
      }
    }
    __builtin_amdgcn_s_setprio(0);
  }
  __syncthreads();
}

#define EPI_SETUP                                                   \
  const int lane = tidx() & 63, wave = tidx() >> 6;       \
  const int wm = (wave >> 1) * 64, wn = (wave & 1) * 64;            \
  const int lm = lane & 15, ln4 = (lane >> 4) * 4;

__device__ __forceinline__ void store_bf4(u16* dst, f32x4 v) {
  u32x2 o;
  o.x = pack_bf16(v[0], v[1]);
  o.y = pack_bf16(v[2], v[3]);
  *(u32x2*)dst = o;
}

__device__ void transpose_job(const float* __restrict__ src, u16* __restrict__ dst, int K, int N, int nbatch, char* smem) {
  float* tile = (float*)smem;
  const int tk = K / 64, tn = N / 64;
  const int total = nbatch * tk * tn;
  const int tid = tidx();
  const int row0 = tid >> 4, col = (tid & 15) * 4;
  f32x4 v[4];
  int t = bidx();
  if (t < total) {
    int bb = t / (tk * tn), r = t % (tk * tn);
    const float* sp = src + (size_t)bb * K * N + (size_t)((r / tn) * 64) * N + (r % tn) * 64;
#pragma unroll
    for (int i = 0; i < 4; ++i) v[i] = *(const f32x4*)(sp + (size_t)(row0 + i * 16) * N + col);
  }
  for (; t < total; t += gridDim.x) {
    int bb = t / (tk * tn), r = t % (tk * tn);
    int kt = r / tn, nt = r % tn;
    u16* d = dst + (size_t)bb * K * N + (size_t)(nt * 64) * K + kt * 64;
    __syncthreads();
#pragma unroll
    for (int i = 0; i < 4; ++i) {
      int row = row0 + i * 16;
      tile[row * 65 + col + 0] = v[i][0];
      tile[row * 65 + col + 1] = v[i][1];
      tile[row * 65 + col + 2] = v[i][2];
      tile[row * 65 + col + 3] = v[i][3];
    }
    __syncthreads();
    const int tn2 = t + gridDim.x;
    if (tn2 < total) {
      int b2 = tn2 / (tk * tn), r2 = tn2 % (tk * tn);
      const float* sp = src + (size_t)b2 * K * N + (size_t)((r2 / tn) * 64) * N + (r2 % tn) * 64;
#pragma unroll
      for (int i = 0; i < 4; ++i) v[i] = *(const f32x4*)(sp + (size_t)(row0 + i * 16) * N + col);
    }
    int n = tid >> 2, kc = (tid & 3) * 16;
    u32 o[8];
#pragma unroll
    for (int i = 0; i < 8; ++i) o[i] = pack_bf16(tile[(kc + 2 * i) * 65 + n], tile[(kc + 2 * i + 1) * 65 + n]);
    *(u32x4*)(d + (size_t)n * K + kc) = (u32x4){o[0], o[1], o[2], o[3]};
    *(u32x4*)(d + (size_t)n * K + kc + 8) = (u32x4){o[4], o[5], o[6], o[7]};
  }
}

__device__ void transpose_fp8_job(const float* __restrict__ src, size_t ld_src, size_t batch_stride, unsigned char* __restrict__ dst,
                                  int K, int N, int nbatch, float scale, char* smem) {
  float* tile = (float*)smem;
  const int tk = K / 64, tn = N / 64;
  const int total = nbatch * tk * tn;
  const int tid = tidx();
  for (int t = bidx(); t < total; t += gridDim.x) {
    int bb = t / (tk * tn), r = t % (tk * tn);
    int kt = r / tn, nt = r % tn;
    const float* sp = src + (size_t)bb * batch_stride + (size_t)(kt * 64) * ld_src + nt * 64;
    unsigned char* d = dst + (size_t)bb * K * N + (size_t)(nt * 64) * K + kt * 64;
    __syncthreads();
#pragma unroll
    for (int i = 0; i < 4; ++i) {
      int row = (tid >> 4) + i * 16, col = (tid & 15) * 4;
      f32x4 v = *(const f32x4*)(sp + (size_t)row * ld_src + col);
      tile[row * 65 + col + 0] = v[0];
      tile[row * 65 + col + 1] = v[1];
      tile[row * 65 + col + 2] = v[2];
      tile[row * 65 + col + 3] = v[3];
    }
    __syncthreads();
    int n = tid >> 2, kc = (tid & 3) * 16;
    u32x4 q;
    int w;
#pragma unroll
    for (int g4 = 0; g4 < 4; ++g4) {
      w = 0;
      w = __builtin_amdgcn_cvt_pk_fp8_f32(tile[(kc + g4 * 4 + 0) * 65 + n] * scale, tile[(kc + g4 * 4 + 1) * 65 + n] * scale, w, false);
      w = __builtin_amdgcn_cvt_pk_fp8_f32(tile[(kc + g4 * 4 + 2) * 65 + n] * scale, tile[(kc + g4 * 4 + 3) * 65 + n] * scale, w, true);
      q[g4] = (u32)w;
    }
    *(u32x4*)(d + (size_t)n * K + kc) = q;
  }
}

__device__ void convert_job(const float* __restrict__ src, u16* __restrict__ dst, size_t n) {
  size_t n8 = n / 8;
  for (size_t i = (size_t)bidx() * blockDim.x + tidx(); i < n8; i += (size_t)gridDim.x * blockDim.x) {
    f32x4 a = *(const f32x4*)(src + i * 8), b = *(const f32x4*)(src + i * 8 + 4);
    *(u32x4*)(dst + i * 8) = (u32x4){pack_bf16(a.x, a.y), pack_bf16(a.z, a.w), pack_bf16(b.x, b.y), pack_bf16(b.z, b.w)};
  }
}


typedef __attribute__((ext_vector_type(2))) float f32x2_t;
__device__ void fp8_rows_job(const float* __restrict__ src, unsigned char* __restrict__ dst, float* __restrict__ inv_scale, int nrows, int skip_blocks) {
  const int lane = tidx() & 63;
  const int gw = (bidx() - skip_blocks) * 4 + (tidx() >> 6), nw = ((int)gridDim.x - skip_blocks) * 4;
  if (gw < 0) return;
  f32x4 n0 = {0.f, 0.f, 0.f, 0.f}, n1 = n0, n2 = n0, n3 = n0;
  if (gw < nrows) {
    const float* row = src + (size_t)gw * 1024 + lane * 16;
    n0 = *(const f32x4*)row; n1 = *(const f32x4*)(row + 4); n2 = *(const f32x4*)(row + 8); n3 = *(const f32x4*)(row + 12);
  }
  for (int r = gw; r < nrows; r += nw) {
    const f32x4 v0 = n0, v1 = n1, v2 = n2, v3 = n3;
    if (r + nw < nrows) {
      const float* row = src + (size_t)(r + nw) * 1024 + lane * 16;
      n0 = *(const f32x4*)row; n1 = *(const f32x4*)(row + 4); n2 = *(const f32x4*)(row + 8); n3 = *(const f32x4*)(row + 12);
    }
    float am = 0.f;
#pragma unroll
    for (int k = 0; k < 4; ++k) am = fmaxf(am, fmaxf(fmaxf(fabsf(v0[k]), fabsf(v1[k])), fmaxf(fabsf(v2[k]), fabsf(v3[k]))));
#pragma unroll
    for (int o = 32; o >= 1; o >>= 1) am = fmaxf(am, __shfl_xor(am, o, 64));
    am = fmaxf(am, 1e-30f);
    const float sc = 448.f / am;
    u32x4 q;
    int w;
    w = 0; w = __builtin_amdgcn_cvt_pk_fp8_f32(v0[0] * sc, v0[1] * sc, w, false); w = __builtin_amdgcn_cvt_pk_fp8_f32(v0[2] * sc, v0[3] * sc, w, true); q.x = (u32)w;
    w = 0; w = __builtin_amdgcn_cvt_pk_fp8_f32(v1[0] * sc, v1[1] * sc, w, false); w = __builtin_amdgcn_cvt_pk_fp8_f32(v1[2] * sc, v1[3] * sc, w, true); q.y = (u32)w;
    w = 0; w = __builtin_amdgcn_cvt_pk_fp8_f32(v2[0] * sc, v2[1] * sc, w, false); w = __builtin_amdgcn_cvt_pk_fp8_f32(v2[2] * sc, v2[3] * sc, w, true); q.z = (u32)w;
    w = 0; w = __builtin_amdgcn_cvt_pk_fp8_f32(v3[0] * sc, v3[1] * sc, w, false); w = __builtin_amdgcn_cvt_pk_fp8_f32(v3[2] * sc, v3[3] * sc, w, true); q.w = (u32)w;
    *(u32x4*)(dst + (size_t)r * 2048 + lane * 16) = q;
    if (lane == 0) inv_scale[r] = am * (1.f / 448.f);
  }
}

__device__ void mod_job(KP p, char* smem) {
  float* sc = (float*)smem;
  float* red = sc + 5 * 1024;
  const int tid = tidx();
  for (int task = bidx(); task < DEPTH * 96; task += gridDim.x) {
    int l = task / 96, n0 = (task % 96) * 64;
    __syncthreads();
    for (int i = tid; i < 5 * 1024; i += 256) {
      int g = i >> 10, k = i & 1023;
      float v = g == 0 ? p.c_ctx[k] : p.c[(g - 1) * 1024 + k];
      sc[i] = v * sigmoid_f(v);
    }
    __syncthreads();
    int kc = tid >> 6, n = tid & 63;
    const float* w = p.w_ada + (size_t)l * 1024 * 6144 + (size_t)(kc * 256) * 6144 + n0 + n;
    float a0 = 0, a1 = 0, a2 = 0, a3 = 0, a4 = 0;
#pragma unroll 32
    for (int k = 0; k < 256; ++k) {
      float wv = w[(size_t)k * 6144];
      int kk = kc * 256 + k;
      a0 += sc[kk] * wv;
      a1 += sc[1024 + kk] * wv;
      a2 += sc[2048 + kk] * wv;
      a3 += sc[3072 + kk] * wv;
      a4 += sc[4096 + kk] * wv;
    }
    red[(kc * 5 + 0) * 64 + n] = a0;
    red[(kc * 5 + 1) * 64 + n] = a1;
    red[(kc * 5 + 2) * 64 + n] = a2;
    red[(kc * 5 + 3) * 64 + n] = a3;
    red[(kc * 5 + 4) * 64 + n] = a4;
    __syncthreads();
    for (int i = tid; i < 5 * 64; i += 256) {
      int g = i >> 6, nn = i & 63;
      float s = red[(0 * 5 + g) * 64 + nn] + red[(1 * 5 + g) * 64 + nn] + red[(2 * 5 + g) * 64 + nn] + red[(3 * 5 + g) * 64 + nn];
      p.MOD[((size_t)l * 5 + g) * 6144 + n0 + nn] = s + p.b_ada[l * 6144 + n0 + nn];
    }
  }
}

__device__ void tables_job(KP p) {
  const size_t gtid = (size_t)bidx() * blockDim.x + tidx(), gsz = (size_t)gridDim.x * blockDim.x;
  const float TWO_PI = 6.283185307179586f;
  for (size_t i = gtid; i < 256 * 128; i += gsz) {
    int m = (int)(i >> 7), c = (int)(i & 127);
    int cs = m >> 7, cp = m & 127;
    int r = (c * cp) & 127;
    float ang = TWO_PI * (float)r / 128.f;
    float v = cs ? __sinf(ang) : __cosf(ang);
    p.FC[i] = (u16)(pack_bf16(v, 0.f) & 0xffff);
  }
  for (size_t i = gtid; i < 256 * 512; i += gsz) {
    int lp = (int)(i >> 9), k = (int)(i & 511);
    int cs = k >> 8, l = k & 255;
    int r = (l * lp) & 255;
    float ang = TWO_PI * (float)r / 256.f;
    float sc = 0.005524271728019903f;
    float v = cs ? -__sinf(ang) * sc : __cosf(ang) * sc;
    p.FL256[i] = (u16)(pack_bf16(v, 0.f) & 0xffff);
  }
  for (size_t i = gtid; i < 1024 * 2048; i += gsz) {
    int lp = (int)(i >> 11), k = (int)(i & 2047);
    int cs = k >> 10, l = k & 1023;
    int r = (l * lp) & 1023;
    float ang = TWO_PI * (float)r / 1024.f;
    float sc = 0.0027621358640099515f;
    float v = cs ? -__sinf(ang) * sc : __cosf(ang) * sc;
    p.FL1024[i] = (u16)(pack_bf16(v, 0.f) & 0xffff);
  }
  for (size_t i = gtid; i < 1024; i += gsz) {
    int pos = (int)(i >> 4), f = (int)(i & 15);
    float inv = 1.0f / exp2f((float)f * (13.287712379549449f / 16.f));
    float ang = (float)pos * inv;
    p.ROPE[i] = cosf(ang);
    p.ROPE[1024 + i] = sinf(ang);
  }
  for (size_t i = gtid; i < 16 * 128 * 256; i += gsz) {
    int bl = (int)(i >> 15), r = (int)(i & 32767);
    int c = r >> 8, key = r & 255;
    float v = p.cache_v[((size_t)bl * 256 + key) * 128 + c];
    p.CVT16[i] = (u16)(pack_bf16(v, 0.f) & 0xffff);
  }
}

__device__ void prologue0(KP p, char* smem) {
  mod_job(p, smem);
  transpose_job(p.w_in, p.WinT, 1024, NCOL, DEPTH, smem);
  transpose_fp8_job(p.w_in + 3328, NCOL, (size_t)1024 * NCOL, p.WgT8, 1024, 4096, DEPTH, 64.f, smem);
  transpose_job(p.w_glu, p.WgluT, 512, 512, DEPTH, smem);
  transpose_job(p.w_branch, p.WbrT, 512, 1024, DEPTH * 4, smem);
  transpose_job(p.w_out, p.WoutT, 1024, 1024, DEPTH, smem);
  transpose_job(p.peer_wq, p.WqT, 1024, 2048, DEPTH, smem);
  tables_job(p);
  convert_job(p.subkeys, p.SK16, (size_t)DEPTH * 8 * 2 * 128 * 128);
  convert_job(p.cache_k, p.CK16, (size_t)4 * DEPTH * 256 * 128);
}

__device__ void prologue1(KP p) {
  const size_t n4 = (size_t)T_ALL * 256;
  for (size_t i = (size_t)bidx() * blockDim.x + tidx(); i < n4; i += (size_t)gridDim.x * blockDim.x) {
    int t = (int)(i >> 8), c = (int)(i & 255) * 4;
    const float* src = t < T_CTX ? p.x_prompt + (size_t)t * 1024 + c : p.x_sample + (size_t)(t - T_CTX) * 1024 + c;
    f32x4 v = *(const f32x4*)src;
    *(f32x4*)(p.X + (size_t)t * 1024 + c) = v;
    const float* mod = p.MOD + (size_t)mod_group(t) * 6144;
    f32x4 sh = *(const f32x4*)(mod + c), scl = *(const f32x4*)(mod + 1024 + c);
    u32x2 o;
    o.x = pack_bf16(v.x * (1.f + scl.x) + sh.x, v.y * (1.f + scl.y) + sh.y);
    o.y = pack_bf16(v.z * (1.f + scl.z) + sh.z, v.w * (1.f + scl.w) + sh.w);
    *(u32x2*)(p.XM + (size_t)t * 1024 + c) = o;
    {
      int w8 = 0;
      w8 = __builtin_amdgcn_cvt_pk_fp8_f32(v.x * (1.f + scl.x) + sh.x, v.y * (1.f + scl.y) + sh.y, w8, false);
      w8 = __builtin_amdgcn_cvt_pk_fp8_f32(v.z * (1.f + scl.z) + sh.z, v.w * (1.f + scl.w) + sh.w, w8, true);
      *(int*)(p.XM8 + (size_t)t * 1024 + c) = w8;
    }
  }
}

__device__ void phase_inproj(KP p, int layer, char* smem) {
  const u16* W = p.WinT + (size_t)layer * NCOL * DM;
  const int lane = tidx() & 63, wave = tidx() >> 6;
  const int wm = (wave >> 1) * 128, wn = (wave & 1) * 64;
  const int lm = lane & 15, ln4 = (lane >> 4) * 4;
  for (int tile = bidx(); tile < 48 * 26; tile += gridDim.x) {
    const int mt = tile % 48, nt = tile / 48;
    f32x4 acc[8][4];
    gemm_mainloop_big(p.XM + (size_t)mt * 256 * DM, DM, W + (size_t)nt * 128 * DM, DM, DM, acc, smem);
    const int n0 = nt * 128, t0 = mt * 256;
    const bool lat = t0 >= T_CTX;
    if (n0 < 512) {
#pragma unroll
      for (int i = 0; i < 8; ++i)
#pragma unroll
        for (int j = 0; j < 4; ++j)
          store_bf4(p.ZF + (size_t)(t0 + wm + i * 16 + lm) * 512 + n0 + wn + j * 16 + ln4, acc[i][j]);
    } else if (n0 < 2048) {
#pragma unroll
      for (int i = 0; i < 8; ++i)
#pragma unroll
        for (int j = 0; j < 4; ++j)
          store_bf4(p.ZCV + (size_t)(t0 + wm + i * 16 + lm) * 1536 + (n0 - 512) + wn + j * 16 + ln4, acc[i][j]);
    } else if (n0 < 2560) {
#pragma unroll
      for (int i = 0; i < 8; ++i)
#pragma unroll
        for (int j = 0; j < 4; ++j)
          *(f32x4*)(p.ZS + (size_t)(t0 + wm + i * 16 + lm) * 512 + (n0 - 2048) + wn + j * 16 + ln4) = acc[i][j];
    } else if (n0 < 3200) {
      const bool isq = n0 < 3072;
#pragma unroll
      for (int i = 0; i < 8; ++i) {
        const int t = t0 + wm + i * 16 + lm;
        const int l = (t - T_CTX) & 1023;
#pragma unroll
        for (int half = 0; half < 2; ++half) {
          f32x4 o1 = acc[i][half * 2], o2 = acc[i][half * 2 + 1];
          if (lat) {
            const int pos = half == 0 ? (l >> 6) : (l & 63);
            const f32x4 cs = *(const f32x4*)(p.ROPE + pos * 16 + ln4);
            const f32x4 sn = *(const f32x4*)(p.ROPE + 1024 + pos * 16 + ln4);
            const f32x4 x1 = o1, x2 = o2;
            o1 = x1 * cs - x2 * sn;
            o2 = x2 * cs + x1 * sn;
          }
          const int c = wn + half * 32 + ln4;
          if (isq) {
            store_bf4(p.Q16 + (size_t)t * 512 + (n0 - 2560) + c, o1);
            store_bf4(p.Q16 + (size_t)t * 512 + (n0 - 2560) + c + 16, o2);
          } else {
            store_bf4(p.K16 + (size_t)t * 128 + c, o1);
            store_bf4(p.K16 + (size_t)t * 128 + c + 16, o2);
            if (!lat) {
              const int b = t >> 8, ll = t & 255;
              float* ko = p.out + (size_t)12582912 + (((size_t)(b * DEPTH + layer) * 256 + ll) * 128 + c);
              *(f32x4*)ko = o1;
              *(f32x4*)(ko + 16) = o2;
            }
          }
        }
      }
    } else if (n0 < 3328) {
#pragma unroll
      for (int i = 0; i < 8; ++i)
#pragma unroll
        for (int j = 0; j < 4; ++j) {
          const int t = t0 + wm + i * 16 + lm, c = wn + j * 16 + ln4;
          if (!lat) {
            const int b = t >> 8, ll = t & 255;
            *(f32x4*)(p.out + (size_t)16777216 + (((size_t)(b * DEPTH + layer) * 256 + ll) * 128 + c)) = acc[i][j];
#pragma unroll
            for (int r = 0; r < 4; ++r)
              p.VT[((size_t)(b * 128 + c + r)) * 256 + ll] = (u16)(pack_bf16(acc[i][j][r], 0.f) & 0xffff);
          } else {
            const int b = (t - T_CTX) >> 10, ll = (t - T_CTX) & 1023;
#pragma unroll
            for (int r = 0; r < 4; ++r)
              p.VT[(size_t)T_CTX * 128 + ((size_t)(b * 128 + c + r)) * 1024 + ll] = (u16)(pack_bf16(acc[i][j][r], 0.f) & 0xffff);
          }
        }
    }
  }
}

__device__ void fft1_tile(KP p, int tile, char* smem) {
  EPI_SETUP
  int s, g, mt, ntile, L, tok0;
  u16* dst;
  if (tile < 256) {
    int sg = tile >> 4, r = tile & 15;
    s = sg >> 2; g = sg & 3; mt = r >> 3; ntile = r & 7; L = 1024; tok0 = T_CTX + s * 1024;
    dst = p.TTt + (size_t)T_CTX * 4 * 256 + (size_t)sg * 128 * 2048;
  } else {
    int tt = tile - 256;
    int sg = tt >> 2, r = tt & 3;
    s = sg >> 2; g = sg & 3; mt = r >> 1; ntile = r & 1; L = 256; tok0 = s * 256;
    dst = p.TTt + (size_t)sg * 128 * 512;
  }
  f32x4 acc[4][4];
  gemm_mainloop(p.FC + (size_t)mt * 128 * 128, 128, p.ZF + (size_t)(tok0 + ntile * 128) * 512 + g * 128, 512, 128, acc, smem);
#pragma unroll
  for (int i = 0; i < 4; ++i)
#pragma unroll
    for (int j = 0; j < 4; ++j) {
      int cp = wm + i * 16 + lm;
      int l = ntile * 128 + wn + j * 16 + ln4;
      store_bf4(dst + (size_t)cp * (2 * L) + mt * L + l, acc[i][j]);
    }
}

__device__ void conv_job(KP p, int layer, int chunk, int nchunks) {
  const float* cw = p.conv_w + (size_t)layer * 3 * 512;
  u16* Y = p.Y4 + (size_t)T_ALL * 512;
  const size_t total = (size_t)T_ALL * 64;
  for (size_t i = (size_t)chunk * 256 + tidx(); i < total; i += (size_t)nchunks * 256) {
    int t = (int)(i >> 6), ch = (int)(i & 63) * 8;
    int l, L;
    if (t < T_CTX) { l = t & 255; L = 256; } else { l = (t - T_CTX) & 1023; L = 1024; }
    const u16* row = p.ZCV + (size_t)t * 1536;
    u32x4 zb = *(const u32x4*)(row + ch);
    u32x4 c0 = *(const u32x4*)(row + 512 + ch), h0 = *(const u32x4*)(row + 1024 + ch);
    u32x4 cm = (u32x4){0, 0, 0, 0}, hm = cm, cp = cm, hp = cm;
    if (l > 0) { cm = *(const u32x4*)(row - 1536 + 512 + ch); hm = *(const u32x4*)(row - 1536 + 1024 + ch); }
    if (l < L - 1) { cp = *(const u32x4*)(row + 1536 + 512 + ch); hp = *(const u32x4*)(row + 1536 + 1024 + ch); }
    const u32* zbw = (const u32*)&zb; const u32* c0w = (const u32*)&c0; const u32* h0w = (const u32*)&h0;
    const u32* cmw = (const u32*)&cm; const u32* hmw = (const u32*)&hm; const u32* cpw = (const u32*)&cp; const u32* hpw = (const u32*)&hp;
    u32 o[4];
#pragma unroll
    for (int w = 0; w < 4; ++w) {
      int c = ch + w * 2;
      float r0 = bf_lo(zbw[w]) * (cw[c] * bf_lo(cmw[w]) * bf_lo(hmw[w]) + cw[512 + c] * bf_lo(c0w[w]) * bf_lo(h0w[w]) +
                                  cw[1024 + c] * bf_lo(cpw[w]) * bf_lo(hpw[w]));
      float r1 = bf_hi(zbw[w]) * (cw[c + 1] * bf_hi(cmw[w]) * bf_hi(hmw[w]) + cw[512 + c + 1] * bf_hi(c0w[w]) * bf_hi(h0w[w]) +
                                  cw[1024 + c + 1] * bf_hi(cpw[w]) * bf_hi(hpw[w]));
      o[w] = pack_bf16(r0, r1);
    }
    *(u32x4*)(Y + (size_t)t * 512 + ch) = (u32x4){o[0], o[1], o[2], o[3]};
  }
}

#define BU_STR 20
#define H_STR 68
__device__ __forceinline__ void s5_pass(KP p, int layer, const int DIR, int b, int g, int L, int tok0, bool lat, float* BU, u32* Hs,
                                        u16* __restrict__ ydst) {
  const int lane = tidx() & 63;
  const int lm = lane & 15, slab = lane >> 4;
  const int pidx = (layer * 2 + DIR) * 32 + g;
  const float dt = expf(p.log_step[pidx]);
  bf16x8 bfrag[8];
#pragma unroll
  for (int nt = 0; nt < 4; ++nt) {
    int st = nt * 16 + lm;
    float lr = p.lam_re[pidx * 64 + st], li = p.lam_im[pidx * 64 + st];
    float a = lr * dt, bb = li * dt;
    float em1 = expm1f(a);
    float sb, cb;
    sincosf(bb, &sb, &cb);
    float sh = sinf(0.5f * bb);
    float nr = em1 * cb - 2.f * sh * sh;
    float ni = (em1 + 1.f) * sb;
    float den = 1.f / (lr * lr + li * li);
    float cr = (nr * lr + ni * li) * den, ci = (ni * lr - nr * li) * den;
    u32x4 fre = (u32x4){0, 0, 0, 0}, fim = fre;
    if (slab < 2) {
      const float* br = p.b_re + ((size_t)pidx * 64 + st) * 16 + slab * 8;
      const float* bi = p.b_im + ((size_t)pidx * 64 + st) * 16 + slab * 8;
      f32x4 r0 = *(const f32x4*)br, r1 = *(const f32x4*)(br + 4), i0 = *(const f32x4*)bi, i1 = *(const f32x4*)(bi + 4);
      fre.x = pack_bf16(cr * r0.x - ci * i0.x, cr * r0.y - ci * i0.y);
      fre.y = pack_bf16(cr * r0.z - ci * i0.z, cr * r0.w - ci * i0.w);
      fre.z = pack_bf16(cr * r1.x - ci * i1.x, cr * r1.y - ci * i1.y);
      fre.w = pack_bf16(cr * r1.z - ci * i1.z, cr * r1.w - ci * i1.w);
      fim.x = pack_bf16(cr * i0.x + ci * r0.x, cr * i0.y + ci * r0.y);
      fim.y = pack_bf16(cr * i0.z + ci * r0.z, cr * i0.w + ci * r0.w);
      fim.z = pack_bf16(cr * i1.x + ci * r1.x, cr * i1.y + ci * r1.y);
      fim.w = pack_bf16(cr * i1.z + ci * r1.z, cr * i1.w + ci * r1.w);
    }
    bfrag[nt] = as_bf16x8(fre);
    bfrag[nt + 4] = as_bf16x8(fim);
  }
  bf16x8 cfrag[4];
#pragma unroll
  for (int ks = 0; ks < 4; ++ks) {
    const float* cr = p.c_re + ((size_t)pidx * 16 + lm) * 64 + ks * 16 + slab * 4;
    const float* ci = p.c_im + ((size_t)pidx * 16 + lm) * 64 + ks * 16 + slab * 4;
    f32x4 r = *(const f32x4*)cr, im = *(const f32x4*)ci;
    u32x4 f;
    f.x = pack_bf16(r.x, -im.x);
    f.y = pack_bf16(r.y, -im.y);
    f.z = pack_bf16(r.z, -im.z);
    f.w = pack_bf16(r.w, -im.w);
    cfrag[ks] = as_bf16x8(f);
  }
  float ar, ai;
  {
    float lr = p.lam_re[pidx * 64 + lane], li = p.lam_im[pidx * 64 + lane];
    float e = expf(lr * dt);
    float sb, cb;
    sincosf(li * dt, &sb, &cb);
    ar = e * cb; ai = e * sb;
  }
  float hr = 0.f, hi = 0.f;
  if (lat) {
    size_t o = (((size_t)(b * DEPTH + layer) * 2 + DIR) * 32 + g) * 64 + lane;
    hr = p.st_re[o]; hi = p.st_im[o];
  }
  const int nb = L / 16;
  const int tstep = DIR ? -16 : 16;
  int tb = DIR ? (L - 16) : 0;
  const float* ubase = p.ZS + (size_t)(tok0 + lm) * 512 + g * 16 + (slab & 1) * 8;
  f32x4 u0n = {0.f, 0.f, 0.f, 0.f}, u1n = u0n;
  if (slab < 2) { const float* up = ubase + (size_t)tb * 512; u0n = *(const f32x4*)up; u1n = *(const f32x4*)(up + 4); }
  for (int bi = 0; bi < nb; ++bi, tb += tstep) {
    u32x4 uf = (u32x4){0, 0, 0, 0};
    if (slab < 2) uf = (u32x4){pack_bf16(u0n.x, u0n.y), pack_bf16(u0n.z, u0n.w), pack_bf16(u1n.x, u1n.y), pack_bf16(u1n.z, u1n.w)};
    if (slab < 2 && bi + 1 < nb) { const float* up = ubase + (size_t)(tb + tstep) * 512; u0n = *(const f32x4*)up; u1n = *(const f32x4*)(up + 4); }
    bf16x8 ufrag = as_bf16x8(uf);
#pragma unroll
    for (int nt = 0; nt < 8; ++nt) {
      f32x4 z = {0.f, 0.f, 0.f, 0.f};
      f32x4 r = __builtin_amdgcn_mfma_f32_16x16x32_bf16(ufrag, bfrag[nt], z, 0, 0, 0);
      *(f32x4*)(BU + (nt * 16 + lm) * BU_STR + slab * 4) = r;
    }
    __syncthreads();
    float bre[16], bim[16];
#pragma unroll
    for (int q = 0; q < 4; ++q) {
      f32x4 a = *(const f32x4*)(BU + lane * BU_STR + q * 4);
      f32x4 c = *(const f32x4*)(BU + (64 + lane) * BU_STR + q * 4);
      bre[q * 4 + 0] = a[0]; bre[q * 4 + 1] = a[1]; bre[q * 4 + 2] = a[2]; bre[q * 4 + 3] = a[3];
      bim[q * 4 + 0] = c[0]; bim[q * 4 + 1] = c[1]; bim[q * 4 + 2] = c[2]; bim[q * 4 + 3] = c[3];
    }
    if (DIR) {
#pragma unroll
      for (int s = 15; s >= 0; --s) {
        float nr = ar * hr - ai * hi + bre[s];
        float ni = ar * hi + ai * hr + bim[s];
        hr = nr; hi = ni;
        Hs[s * H_STR + lane] = pack_bf16(hr, hi);
      }
    } else {
#pragma unroll
      for (int s = 0; s < 16; ++s) {
        float nr = ar * hr - ai * hi + bre[s];
        float ni = ar * hi + ai * hr + bim[s];
        hr = nr; hi = ni;
        Hs[s * H_STR + lane] = pack_bf16(hr, hi);
      }
    }
    __syncthreads();
    f32x4 y = {0.f, 0.f, 0.f, 0.f};
#pragma unroll
    for (int ks = 0; ks < 4; ++ks) {
      bf16x8 hf = *(const bf16x8*)(Hs + lm * H_STR + ks * 16 + slab * 4);
      y = __builtin_amdgcn_mfma_f32_16x16x32_bf16(cfrag[ks], hf, y, 0, 0, 0);
    }
    store_bf4(ydst + (size_t)(tok0 + tb + lm) * 512 + g * 16 + slab * 4, y);
  }
  if (!lat) {
    size_t o = (((size_t)(b * DEPTH + layer) * 2 + DIR) * 32 + g) * 64 + lane;
    p.out[(size_t)20971520 + o] = hr;
    p.out[(size_t)20971520 + 524288 + o] = hi;
  }
}

__device__ void s5_block(KP p, int layer, int btask, char* smem) {
  const int wave = tidx() >> 6;
  float* BU = (float*)(smem + wave * (128 * BU_STR * 4 + 16 * H_STR * 4));
  u32* Hs = (u32*)(BU + 128 * BU_STR);
  u16* YFW = p.MERGED;
  const bool lat = btask < 64;
  int b, g, L, tok0;
  if (lat) { const int task = (btask >> 1) * 4 + wave; b = task >> 5; g = task & 31; L = 1024; tok0 = T_CTX + b * 1024; }
  else { const int tt = (btask - 64) * 4 + wave; b = tt >> 5; g = tt & 31; L = 256; tok0 = b * 256; }
  const int npass = lat ? 1 : 2;
  for (int pass = 0; pass < npass; ++pass) {
    const int dir = lat ? (btask & 1) : (1 - pass);
    if (dir) s5_pass(p, layer, 1, b, g, L, tok0, lat, BU, Hs, (u16*)p.YBK);
    else s5_pass(p, layer, 0, b, g, L, tok0, lat, BU, Hs, YFW);
  }
}

struct AttnSrc { const u16* Kl; const u16* Vl; const u16* Kc; const u16* Vc; int nloc; int klo; int ldl; };

__device__ __forceinline__ void attn_load(const AttnSrc& a, int i, int lm, int slab, bf16x8 (&kf)[2][2], bf16x8 (&vf)[4]) {
  const bool loc = i < a.nloc;
  const u16* Kp = loc ? a.Kl : a.Kc;
  const u16* Vp = loc ? a.Vl : a.Vc;
  const int ldvt = loc ? a.ldl : 256;
  const int kb = loc ? a.klo + i * 32 : (i - a.nloc) * 32;
#pragma unroll
  for (int kt = 0; kt < 2; ++kt) {
    const u16* kr = Kp + (size_t)(kb + kt * 16 + lm) * 128 + slab * 8;
    kf[kt][0] = *(const bf16x8*)kr;
    kf[kt][1] = *(const bf16x8*)(kr + 32);
  }
#pragma unroll
  for (int dt = 0; dt < 4; ++dt) {
    const u16* vr = Vp + (size_t)(dt * 16 + lm) * ldvt + kb + slab * 4;
    u32x2 v0 = *(const u32x2*)vr, v1 = *(const u32x2*)(vr + 16);
    vf[dt] = as_bf16x8((u32x4){v0.x, v0.y, v1.x, v1.y});
  }
}

__device__ void attn_wave(KP p, int layer, int wtask) {
  const int lane = tidx() & 63;
  const int lm = lane & 15, slab = lane >> 4;
  int b, kvh, q0, tok0;
  AttnSrc a;
  if (wtask < 512) {
    b = wtask >> 7; kvh = (wtask >> 6) & 1; q0 = (wtask & 63) * 16; tok0 = T_CTX + b * 1024;
    int klo = q0 - 128; if (klo < 0) klo = 0; klo &= ~31;
    int khi = q0 + 15 + 128; if (khi > 1023) khi = 1023;
    a.klo = klo; a.nloc = (khi - klo) / 32 + 1; a.ldl = 1024;
    a.Kl = p.K16 + (size_t)tok0 * 128 + kvh * 64;
    a.Vl = p.VT + (size_t)T_CTX * 128 + (size_t)b * 128 * 1024 + (size_t)kvh * 64 * 1024;
    a.Kc = p.CK16 + (size_t)(b * DEPTH + layer) * 256 * 128 + kvh * 64;
    a.Vc = p.CVT16 + (size_t)(b * DEPTH + layer) * 128 * 256 + (size_t)kvh * 64 * 256;
  } else {
    int tt = wtask - 512;
    b = tt >> 5; kvh = (tt >> 4) & 1; q0 = (tt & 15) * 16; tok0 = b * 256;
    a.klo = 0; a.nloc = 0; a.ldl = 256;
    a.Kc = p.K16 + (size_t)tok0 * 128 + kvh * 64;
    a.Vc = p.VT + (size_t)b * 128 * 256 + (size_t)kvh * 64 * 256;
    a.Kl = a.Kc; a.Vl = a.Vc;
  }
  const int nblk = a.nloc + 8;
  bf16x8 qf[4][2];
#pragma unroll
  for (int hh = 0; hh < 4; ++hh) {
    const u16* qr = p.Q16 + (size_t)(tok0 + q0 + lm) * 512 + (kvh * 4 + hh) * 64 + slab * 8;
    qf[hh][0] = *(const bf16x8*)qr;
    qf[hh][1] = *(const bf16x8*)(qr + 32);
  }
  f32x4 o[4][4];
  float m[4], lsum[4];
#pragma unroll
  for (int hh = 0; hh < 4; ++hh) {
#pragma unroll
    for (int dt = 0; dt < 4; ++dt) o[hh][dt] = (f32x4){0.f, 0.f, 0.f, 0.f};
    m[hh] = p.sink[layer * 8 + kvh * 4 + hh];
    lsum[hh] = slab == 0 ? 1.f : 0.f;
  }
  const int qp = q0 + lm;
  bf16x8 kn[2][2], vn[4];
  attn_load(a, 0, lm, slab, kn, vn);
  for (int i = 0; i < nblk; ++i) {
    bf16x8 kc[2][2], vc[4];
#pragma unroll
    for (int kt = 0; kt < 2; ++kt) { kc[kt][0] = kn[kt][0]; kc[kt][1] = kn[kt][1]; }
#pragma unroll
    for (int dt = 0; dt < 4; ++dt) vc[dt] = vn[dt];
    if (i + 1 < nblk) attn_load(a, i + 1, lm, slab, kn, vn);
    const bool domask = i < a.nloc;
    const int kb = a.klo + i * 32;
#pragma unroll
    for (int hh = 0; hh < 4; ++hh) {
      f32x4 s[2];
#pragma unroll
      for (int kt = 0; kt < 2; ++kt) {
        f32x4 z = {0.f, 0.f, 0.f, 0.f};
        z = __builtin_amdgcn_mfma_f32_16x16x32_bf16(kc[kt][0], qf[hh][0], z, 0, 0, 0);
        z = __builtin_amdgcn_mfma_f32_16x16x32_bf16(kc[kt][1], qf[hh][1], z, 0, 0, 0);
        s[kt] = z * 0.125f;
      }
      if (domask) {
#pragma unroll
        for (int kt = 0; kt < 2; ++kt)
#pragma unroll
          for (int r = 0; r < 4; ++r) {
            int d = qp - (kb + kt * 16 + slab * 4 + r);
            if (d > 128 || d < -128) s[kt][r] = -1e30f;
          }
      }
      float mx = fmaxf(fmaxf(fmaxf(s[0][0], s[0][1]), fmaxf(s[0][2], s[0][3])), fmaxf(fmaxf(s[1][0], s[1][1]), fmaxf(s[1][2], s[1][3])));
      mx = fmaxf(mx, __shfl_xor(mx, 16, 64));
      mx = fmaxf(mx, __shfl_xor(mx, 32, 64));
      const float mn = fmaxf(m[hh], mx);
      const float alpha = __expf(m[hh] - mn);
      m[hh] = mn;
      float ps = 0.f;
#pragma unroll
      for (int kt = 0; kt < 2; ++kt)
#pragma unroll
        for (int r = 0; r < 4; ++r) {
          float e = __expf(s[kt][r] - mn);
          s[kt][r] = e;
          ps += e;
        }
      lsum[hh] = lsum[hh] * alpha + ps;
      const bf16x8 pfr = as_bf16x8((u32x4){pack_bf16(s[0][0], s[0][1]), pack_bf16(s[0][2], s[0][3]), pack_bf16(s[1][0], s[1][1]), pack_bf16(s[1][2], s[1][3])});
#pragma unroll
      for (int dt = 0; dt < 4; ++dt) {
        o[hh][dt] = o[hh][dt] * alpha;
        o[hh][dt] = __builtin_amdgcn_mfma_f32_16x16x32_bf16(vc[dt], pfr, o[hh][dt], 0, 0, 0);
      }
    }
  }
  u16* Y = p.Y4 + (size_t)3 * T_ALL * 512;
#pragma unroll
  for (int hh = 0; hh < 4; ++hh) {
    float l = lsum[hh];
    l += __shfl_xor(l, 16, 64);
    l += __shfl_xor(l, 32, 64);
    const float inv = 1.f / l;
#pragma unroll
    for (int dt = 0; dt < 4; ++dt)
      store_bf4(Y + (size_t)(tok0 + q0 + lm) * 512 + (kvh * 4 + hh) * 64 + dt * 16 + slab * 4, o[hh][dt] * inv);
  }
}

__device__ void phase_mix(KP p, int layer, char* smem) {
  const int NS5 = 320, NATT = 384, NFFT = 768, NCONV = 512;
  for (int task = bidx(); task < NS5 + NATT + NFFT + NCONV; task += gridDim.x) {
    if (task < NS5) s5_block(p, layer, task, smem);
    else if (task < NS5 + NATT) attn_wave(p, layer, (task - NS5) * 4 + (tidx() >> 6));
    else if (task < NS5 + NATT + NFFT) fft1_tile(p, task - NS5 - NATT, smem);
    else conv_job(p, layer, task - NS5 - NATT - NFFT, NCONV);
  }
  const size_t toff = (size_t)layer * 16384 * 1024;
  fp8_rows_job(p.peer_u + toff, p.U8 + 2 * toff, p.SCU + layer * 16384, 16384, 64);
  fp8_rows_job(p.peer_v + toff, p.U8 + 2 * toff + 1024, p.SCV + layer * 16384, 16384, 64);
}

__device__ void gates_job(KP p, int layer, char* smem) {
  EPI_SETUP
  for (int tile = bidx(); tile < 96 * 32; tile += gridDim.x) {
    const int mt = tile % 96, nt = tile / 96;
    f32x4 acc[4][4];
    gemm_mainloop_fp8(p.XM8 + (size_t)mt * 128 * DM, DM, p.WgT8 + ((size_t)layer * 4096 + nt * 128) * DM, DM, DM, acc, smem);
#pragma unroll
    for (int i = 0; i < 4; ++i)
#pragma unroll
      for (int j = 0; j < 4; ++j) {
        f32x4 v = acc[i][j] * (1.f / 64.f);
        u32 w = 0;
        w = __builtin_amdgcn_cvt_pk_u8_f32(sigmoid_f(v[0]) * 255.f, 0, w);
        w = __builtin_amdgcn_cvt_pk_u8_f32(sigmoid_f(v[1]) * 255.f, 1, w);
        w = __builtin_amdgcn_cvt_pk_u8_f32(sigmoid_f(v[2]) * 255.f, 2, w);
        w = __builtin_amdgcn_cvt_pk_u8_f32(sigmoid_f(v[3]) * 255.f, 3, w);
        *(u32*)((unsigned char*)p.G + (size_t)(mt * 128 + wm + i * 16 + lm) * 4096 + nt * 128 + wn + j * 16 + ln4) = w;
      }
  }
}

__device__ void phase_s5_combine(KP p, int layer) {
  const u16* YFW = p.MERGED;
  const u16* YBK = (const u16*)p.YBK;
  const float* dsk = p.ssm_d + layer * 512;
  const size_t n4 = (size_t)T_ALL * 128;
  for (size_t i = (size_t)bidx() * 256 + tidx(); i < n4; i += (size_t)gridDim.x * 256) {
    int c = (int)(i & 127) * 4;
    const u32x2 yf = *(const u32x2*)(YFW + i * 4), yb = *(const u32x2*)(YBK + i * 4);
    f32x4 v = (f32x4){bf_lo(yf.x) + bf_lo(yb.x), bf_hi(yf.x) + bf_hi(yb.x), bf_lo(yf.y) + bf_lo(yb.y), bf_hi(yf.y) + bf_hi(yb.y)}
              + *(const f32x4*)(dsk + c) * *(const f32x4*)(p.ZS + i * 4);
    v[0] = gelu_tanh(v[0]); v[1] = gelu_tanh(v[1]); v[2] = gelu_tanh(v[2]); v[3] = gelu_tanh(v[3]);
    store_bf4(p.YS + i * 4, v);
  }
}

__device__ void phase_fft2_glu(KP p, int layer, char* smem) {
  EPI_SETUP
  for (int task = bidx(); task < 128 + 256 + 384; task += gridDim.x) {
    f32x4 acc[4][4];
    if (task < 384) {
      int sg, mt, L, tok0;
      const u16 *A, *B;
      if (task < 128) { sg = task >> 3; mt = task & 7; L = 1024; tok0 = T_CTX + (sg >> 2) * 1024;
                        A = p.FL1024 + (size_t)mt * 128 * 2048; B = p.TTt + (size_t)T_CTX * 4 * 256 + (size_t)sg * 128 * 2048; }
      else { int tt = task - 128; sg = tt >> 1; mt = tt & 1; L = 256; tok0 = (sg >> 2) * 256;
             A = p.FL256 + (size_t)mt * 128 * 512; B = p.TTt + (size_t)sg * 128 * 512; }
      gemm_mainloop(A, 2 * L, B, 2 * L, 2 * L, acc, smem);
      const int g = sg & 3;
#pragma unroll
      for (int i = 0; i < 4; ++i)
#pragma unroll
        for (int j = 0; j < 4; ++j)
          store_bf4(p.Y4 + (size_t)(tok0 + mt * 128 + wm + i * 16 + lm) * 512 + g * 128 + wn + j * 16 + ln4, acc[i][j]);
    } else {
      int tt = task - 384;
      int mt = tt % 96, nt = tt / 96;
      gemm_mainloop(p.YS + (size_t)mt * 128 * 512, 512, p.WgluT + (size_t)layer * 512 * 512 + (size_t)nt * 128 * 512, 512, 512, acc, smem);
      u16* Y = p.Y4 + (size_t)2 * T_ALL * 512;
#pragma unroll
      for (int i = 0; i < 4; ++i)
#pragma unroll
        for (int j = 0; j < 4; ++j) {
          size_t a = (size_t)(mt * 128 + wm + i * 16 + lm) * 512 + nt * 128 + wn + j * 16 + ln4;
          u32x2 ys = *(const u32x2*)(p.YS + a);
          f32x4 v = acc[i][j];
          v[0] = bf_lo(ys.x) * sigmoid_f(v[0]);
          v[1] = bf_hi(ys.x) * sigmoid_f(v[1]);
          v[2] = bf_lo(ys.y) * sigmoid_f(v[2]);
          v[3] = bf_hi(ys.y) * sigmoid_f(v[3]);
          store_bf4(Y + a, v);
        }
    }
  }
}

__device__ void phase_branch(KP p, int layer, char* smem) {
  EPI_SETUP
  for (int tile = bidx(); tile < 96 * 8; tile += gridDim.x) {
    const int mt = tile % 96, nt = tile / 96;
    f32x4 tot[4][4];
#pragma unroll
    for (int i = 0; i < 4; ++i)
#pragma unroll
      for (int j = 0; j < 4; ++j) tot[i][j] = (f32x4){0.f, 0.f, 0.f, 0.f};
#pragma unroll 1
    for (int br = 0; br < 4; ++br) {
      f32x4 acc[4][4];
      gemm_mainloop(p.Y4 + (size_t)br * T_ALL * 512 + (size_t)mt * 128 * 512, 512,
                    p.WbrT + ((size_t)(layer * 4 + br) * 1024 + nt * 128) * 512, 512, 512, acc, smem);
      const unsigned char* gp = (const unsigned char*)p.G + (size_t)(mt * 128 + wm + lm) * 4096 + br * 1024 + nt * 128 + wn + ln4;
#pragma unroll
      for (int i = 0; i < 4; ++i)
#pragma unroll
        for (int j = 0; j < 4; ++j) {
          const u32 gq = *(const u32*)(gp + (size_t)(i * 16) * 4096 + j * 16);
          tot[i][j][0] += (float)(gq & 255u) * acc[i][j][0];
          tot[i][j][1] += (float)((gq >> 8) & 255u) * acc[i][j][1];
          tot[i][j][2] += (float)((gq >> 16) & 255u) * acc[i][j][2];
          tot[i][j][3] += (float)(gq >> 24) * acc[i][j][3];
        }
    }
#pragma unroll
    for (int i = 0; i < 4; ++i)
#pragma unroll
      for (int j = 0; j < 4; ++j)
        store_bf4(p.MERGED + (size_t)(mt * 128 + wm + i * 16 + lm) * 1024 + nt * 128 + wn + j * 16 + ln4, tot[i][j] * (1.f / 255.f));
  }
}

__device__ void phase_outproj(KP p, int layer, char* smem) {
  const int lane = tidx() & 63, wave = tidx() >> 6;
  const int wm = (wave >> 1) * 128, wn = (wave & 1) * 64;
  const int lm = lane & 15, ln4 = (lane >> 4) * 4;
  for (int tile = bidx(); tile < 48 * 8; tile += gridDim.x) {
    const int mt = tile % 48, nt = tile / 48;
    f32x4 acc[8][4];
    gemm_mainloop_big(p.MERGED + (size_t)mt * 256 * 1024, 1024, p.WoutT + ((size_t)layer * 1024 + nt * 128) * 1024, 1024, 1024, acc, smem);
    const float* g1 = p.MOD + ((size_t)layer * 5 + mod_group(mt * 256)) * 6144 + 2048;
#pragma unroll
    for (int i = 0; i < 8; ++i)
#pragma unroll
      for (int j = 0; j < 4; ++j) {
        int n = nt * 128 + wn + j * 16 + ln4;
        size_t a = (size_t)(mt * 256 + wm + i * 16 + lm) * 1024 + n;
        f32x4 x = *(const f32x4*)(p.X + a);
        f32x4 gg = *(const f32x4*)(g1 + n);
        *(f32x4*)(p.R1 + a) = x * ALPHA + gg * acc[i][j];
      }
  }
}

__device__ void phase_ln1(KP p, int layer) {
  const int lane = tidx() & 63;
  const int gw = bidx() * 4 + (tidx() >> 6), nw = gridDim.x * 4;
  const float* gam = p.ln1_g + layer * 1024;
  const float* bet = p.ln1_b + layer * 1024;
  for (int t = gw; t < T_ALL; t += nw) {
    f32x4 v[4];
    float s = 0.f;
#pragma unroll
    for (int i = 0; i < 4; ++i) {
      v[i] = *(const f32x4*)(p.R1 + (size_t)t * 1024 + i * 256 + lane * 4);
      s += v[i][0] + v[i][1] + v[i][2] + v[i][3];
    }
    float mu = wave_sum(s) * (1.f / 1024.f);
    float q = 0.f;
#pragma unroll
    for (int i = 0; i < 4; ++i) {
      v[i] = v[i] - mu;
      q += v[i][0] * v[i][0] + v[i][1] * v[i][1] + v[i][2] * v[i][2] + v[i][3] * v[i][3];
    }
    float rs = rsqrtf(wave_sum(q) * (1.f / 1024.f) + LN_EPS);
    const float* mod = p.MOD + ((size_t)layer * 5 + mod_group(t)) * 6144;
#pragma unroll
    for (int i = 0; i < 4; ++i) {
      int c = i * 256 + lane * 4;
      f32x4 y = v[i] * rs * *(const f32x4*)(gam + c) + *(const f32x4*)(bet + c);
      *(f32x4*)(p.X1 + (size_t)t * 1024 + c) = y;
      f32x4 sh = *(const f32x4*)(mod + 3072 + c), sc = *(const f32x4*)(mod + 4096 + c);
      store_bf4(p.XM2 + (size_t)t * 1024 + c, y * (sc + 1.f) + sh);
    }
  }
}

__device__ void phase_wq(KP p, int layer, char* smem) {
  const int lane = tidx() & 63, wave = tidx() >> 6;
  const int wm = (wave >> 1) * 128, wn = (wave & 1) * 64;
  const int lm = lane & 15, ln4 = (lane >> 4) * 4;
  for (int tile = bidx(); tile < 48 * 16; tile += gridDim.x) {
    const int mt = tile % 48, nt = tile / 48;
    f32x4 acc[8][4];
    gemm_mainloop_big(p.XM2 + (size_t)mt * 256 * 1024, 1024, p.WqT + ((size_t)layer * 2048 + nt * 128) * 1024, 1024, 1024, acc, smem);
#pragma unroll
    for (int i = 0; i < 8; ++i)
#pragma unroll
      for (int j = 0; j < 4; ++j)
        store_bf4(p.PQ + (size_t)(mt * 256 + wm + i * 16 + lm) * 2048 + nt * 128 + wn + j * 16 + ln4, acc[i][j]);
  }
}

__device__ void phase_scores(KP p, int layer, char* smem) {
  EPI_SETUP
  for (int tile = bidx(); tile < 96 * 16; tile += gridDim.x) {
    const int mt = tile % 96, hc = tile / 96;
    f32x4 acc[4][4];
    gemm_mainloop(p.SK16 + ((size_t)layer * 16 + hc) * 128 * 128, 128, p.PQ + (size_t)mt * 128 * 2048 + hc * 128, 2048, 128, acc, smem);
#pragma unroll
    for (int i = 0; i < 4; ++i)
#pragma unroll
      for (int j = 0; j < 4; ++j)
        *(f32x4*)(p.SC + ((size_t)hc * 128 + wm + i * 16 + lm) * T_ALL + mt * 128 + wn + j * 16 + ln4) = acc[i][j];
  }
}

__device__ __forceinline__ u32 ordkey(float f) {
  u32 u = __float_as_uint(f);
  return (u & 0x80000000u) ? ~u : (u | 0x80000000u);
}
__device__ __forceinline__ float unordkey(u32 k) {
  return __uint_as_float((k & 0x80000000u) ? (k ^ 0x80000000u) : ~k);
}
__device__ __forceinline__ void top16_128(const float* __restrict__ s, u32 (&top)[16]) {
#pragma unroll
  for (int j = 0; j < 16; ++j) top[j] = 0u;
  float nxt[16];
#pragma unroll
  for (int e = 0; e < 16; ++e) nxt[e] = s[(size_t)e * T_ALL];
  for (int c = 0; c < 8; ++c) {
    float cur[16];
#pragma unroll
    for (int e = 0; e < 16; ++e) cur[e] = nxt[e];
    if (c + 1 < 8) {
#pragma unroll
      for (int e = 0; e < 16; ++e) nxt[e] = s[(size_t)((c + 1) * 16 + e) * T_ALL];
    }
#pragma unroll
    for (int e = 0; e < 16; ++e) {
      u32 key = (ordkey(cur[e]) & ~0x7Fu) | (u32)(127 - (c * 16 + e));
#pragma unroll
      for (int j = 0; j < 16; ++j) {
        u32 hi = max(top[j], key);
        key = min(top[j], key);
        top[j] = hi;
      }
    }
  }
}

__device__ void phase_topk(KP p, int layer) {
  const int total = T_ALL * 8;
  for (int i = bidx() * 256 + tidx(); i < total; i += gridDim.x * 256) {
    const int h = i / T_ALL, t = i - h * T_ALL;
    const float* s1 = p.SC + ((size_t)(h * 2) * 128) * T_ALL + t;
    const float* s2 = s1 + (size_t)128 * T_ALL;
    u32 top1[16], top2[16];
    top16_128(s1, top1);
    top16_128(s2, top2);
    int i1[16], i2[16];
    float v1[16], v2[16];
#pragma unroll
    for (int a = 0; a < 16; ++a) {
      i1[a] = 127 - (int)(top1[a] & 127u);
      i2[a] = 127 - (int)(top2[a] & 127u);
      v1[a] = unordkey(top1[a] & ~0x7Fu);
      v2[a] = unordkey(top2[a] & ~0x7Fu);
    }
    u32 best[16];
#pragma unroll
    for (int j = 0; j < 16; ++j) best[j] = 0u;
#pragma unroll
    for (int a = 0; a < 16; ++a)
#pragma unroll
      for (int b = 0; b < 16; ++b) {
        if ((a + 1) * (b + 1) <= 16) {
          u32 key = (ordkey(v1[a] + v2[b]) & ~0xFFu) | (u32)(255 - (a * 16 + b));
#pragma unroll
          for (int j = 0; j < 16; ++j) {
            u32 hi = max(best[j], key);
            key = min(best[j], key);
            best[j] = hi;
          }
        }
      }
    float val[16];
    int idx[16];
    float mx = -3.0e38f;
#pragma unroll
    for (int k = 0; k < 16; ++k) {
      int pos = 255 - (int)(best[k] & 255u);
      int a = pos >> 4, b = pos & 15;
      int ia = 0, ib = 0;
      float va = 0.f, vb = 0.f;
#pragma unroll
      for (int j = 0; j < 16; ++j) {
        if (a == j) { ia = i1[j]; va = v1[j]; }
        if (b == j) { ib = i2[j]; vb = v2[j]; }
      }
      val[k] = va + vb;
      idx[k] = ia * 128 + ib;
      mx = fmaxf(mx, val[k]);
    }
    float sum = 0.f;
#pragma unroll
    for (int k = 0; k < 16; ++k) { val[k] = __expf(val[k] - mx); sum += val[k]; }
    float inv = 1.f / sum;
    int* po = p.PIDX + (size_t)t * 128 + h * 16;
    float* pg = p.PG + (size_t)t * 128 + h * 16;
#pragma unroll
    for (int k4 = 0; k4 < 4; ++k4) {
      *(i32x4*)(po + k4 * 4) = (i32x4){idx[k4 * 4], idx[k4 * 4 + 1], idx[k4 * 4 + 2], idx[k4 * 4 + 3]};
      *(f32x4*)(pg + k4 * 4) = (f32x4){val[k4 * 4] * inv, val[k4 * 4 + 1] * inv, val[k4 * 4 + 2] * inv, val[k4 * 4 + 3] * inv};
    }
  }
}

__device__ void phase_peer(KP p, int layer) {
  const int lane = tidx() & 63;
  const int gw = bidx() * 4 + (tidx() >> 6), nw = gridDim.x * 4;
  const unsigned char* U = p.U8 + (size_t)layer * 16384 * 2048;
  const unsigned char* V = U + 1024;
  const float* SU = p.SCU + layer * 16384;
  const float* SV = p.SCV + layer * 16384;
  const float* gam = p.ln2_g + layer * 1024;
  const float* bet = p.ln2_b + layer * 1024;
  for (int t = gw; t < T_ALL; t += nw) {
    f32x2_t x2[8];
    {
      const u32x4 xa = *(const u32x4*)(p.XM2 + (size_t)t * 1024 + lane * 16);
      const u32x4 xb = *(const u32x4*)(p.XM2 + (size_t)t * 1024 + lane * 16 + 8);
      x2[0] = (f32x2_t){bf_lo(xa.x), bf_hi(xa.x)}; x2[1] = (f32x2_t){bf_lo(xa.y), bf_hi(xa.y)};
      x2[2] = (f32x2_t){bf_lo(xa.z), bf_hi(xa.z)}; x2[3] = (f32x2_t){bf_lo(xa.w), bf_hi(xa.w)};
      x2[4] = (f32x2_t){bf_lo(xb.x), bf_hi(xb.x)}; x2[5] = (f32x2_t){bf_lo(xb.y), bf_hi(xb.y)};
      x2[6] = (f32x2_t){bf_lo(xb.z), bf_hi(xb.z)}; x2[7] = (f32x2_t){bf_lo(xb.w), bf_hi(xb.w)};
    }
    const int il0 = p.PIDX[(size_t)t * 128 + lane], il1 = p.PIDX[(size_t)t * 128 + 64 + lane];
    const float su0 = SU[il0], su1 = SU[il1];
    const float gv0 = p.PG[(size_t)t * 128 + lane] * SV[il0], gv1 = p.PG[(size_t)t * 128 + 64 + lane] * SV[il1];
    f32x2_t out[8];
#pragma unroll
    for (int k = 0; k < 8; ++k) out[k] = (f32x2_t){0.f, 0.f};
    for (int e0 = 0; e0 < 128; e0 += 8) {
      const int ilx = e0 < 64 ? il0 : il1;
      const float sux = e0 < 64 ? su0 : su1, gvx = e0 < 64 ? gv0 : gv1;
      u32x4 uq[8], vq[8];
      float cv[8];
#pragma unroll
      for (int q = 0; q < 8; ++q) {
        const int e = (e0 + q) & 63;
        const int id = __builtin_amdgcn_readlane(ilx, e);
        cv[q] = __builtin_bit_cast(float, __builtin_amdgcn_readlane(__builtin_bit_cast(int, gvx), e));
        uq[q] = *(const u32x4*)(U + (size_t)id * 2048 + lane * 16);
        vq[q] = *(const u32x4*)(V + (size_t)id * 2048 + lane * 16);
      }
      float d8[8];
#pragma unroll
      for (int q = 0; q < 8; ++q) {
        f32x2_t acc = (f32x2_t){0.f, 0.f};
#pragma unroll
        for (int w = 0; w < 4; ++w) {
          acc += __builtin_amdgcn_cvt_pk_f32_fp8((int)uq[q][w], false) * x2[w * 2];
          acc += __builtin_amdgcn_cvt_pk_f32_fp8((int)uq[q][w], true) * x2[w * 2 + 1];
        }
        d8[q] = acc.x + acc.y;
      }
      const bool hi32 = (lane & 32) != 0, hi16 = (lane & 16) != 0, hi8 = (lane & 8) != 0;
      float d4[4], d2[2], d1;
#pragma unroll
      for (int k = 0; k < 4; ++k) {
        const float keep = hi32 ? d8[k + 4] : d8[k], send = hi32 ? d8[k] : d8[k + 4];
        d4[k] = keep + __shfl_xor(send, 32, 64);
      }
#pragma unroll
      for (int k = 0; k < 2; ++k) {
        const float keep = hi16 ? d4[k + 2] : d4[k], send = hi16 ? d4[k] : d4[k + 2];
        d2[k] = keep + __shfl_xor(send, 16, 64);
      }
      {
        const float keep = hi8 ? d2[1] : d2[0], send = hi8 ? d2[0] : d2[1];
        d1 = keep + __shfl_xor(send, 8, 64);
      }
      d1 += __shfl_xor(d1, 4, 64);
      d1 += __shfl_xor(d1, 2, 64);
      d1 += __shfl_xor(d1, 1, 64);
#pragma unroll
      for (int q = 0; q < 8; ++q) {
        const int e = (e0 + q) & 63;
        const float dq = __builtin_bit_cast(float, __builtin_amdgcn_readlane(__builtin_bit_cast(int, d1), q * 8));
        const float cu = __builtin_bit_cast(float, __builtin_amdgcn_readlane(__builtin_bit_cast(int, sux), e));
        const float cf = cv[q] * gelu_tanh(dq * cu);
        const f32x2_t cf2 = (f32x2_t){cf, cf};
#pragma unroll
        for (int w = 0; w < 4; ++w) {
          out[w * 2] += cf2 * __builtin_amdgcn_cvt_pk_f32_fp8((int)vq[q][w], false);
          out[w * 2 + 1] += cf2 * __builtin_amdgcn_cvt_pk_f32_fp8((int)vq[q][w], true);
        }
      }
    }
    const float* mod = p.MOD + ((size_t)layer * 5 + mod_group(t)) * 6144;
    float r[16];
    float s = 0.f;
#pragma unroll
    for (int q = 0; q < 4; ++q) {
      int c = lane * 16 + q * 4;
      f32x4 x1 = *(const f32x4*)(p.X1 + (size_t)t * 1024 + c);
      f32x4 g2 = *(const f32x4*)(mod + 5120 + c);
      float o4[4] = {out[q * 2].x, out[q * 2].y, out[q * 2 + 1].x, out[q * 2 + 1].y};
#pragma unroll
      for (int k = 0; k < 4; ++k) {
        float v = ALPHA * x1[k] + g2[k] * o4[k];
        r[q * 4 + k] = v;
        s += v;
      }
    }
    float mu = wave_sum(s) * (1.f / 1024.f);
    float qq = 0.f;
#pragma unroll
    for (int k = 0; k < 16; ++k) { r[k] -= mu; qq += r[k] * r[k]; }
    float rs = rsqrtf(wave_sum(qq) * (1.f / 1024.f) + LN_EPS);
    const bool last = layer == DEPTH - 1;
    float* xo = last ? p.out : p.X;
    const float* modn = p.MOD + ((size_t)(last ? layer : layer + 1) * 5 + mod_group(t)) * 6144;
#pragma unroll
    for (int q = 0; q < 4; ++q) {
      int c = lane * 16 + q * 4;
      f32x4 gg = *(const f32x4*)(gam + c), bb = *(const f32x4*)(bet + c);
      f32x4 y;
#pragma unroll
      for (int k = 0; k < 4; ++k) y[k] = r[q * 4 + k] * rs * gg[k] + bb[k];
      *(f32x4*)(xo + (size_t)t * 1024 + c) = y;
      if (!last) {
        f32x4 sh = *(const f32x4*)(modn + c), sc = *(const f32x4*)(modn + 1024 + c);
        { const f32x4 xm = y * (sc + 1.f) + sh;
          store_bf4(p.XM + (size_t)t * 1024 + c, xm);
          int w8 = 0;
          w8 = __builtin_amdgcn_cvt_pk_fp8_f32(xm[0], xm[1], w8, false);
          w8 = __builtin_amdgcn_cvt_pk_fp8_f32(xm[2], xm[3], w8, true);
          *(int*)(p.XM8 + (size_t)t * 1024 + c) = w8; }
      }
    }
  }
}

#define XB_TMO      128
#define XB_XCNT(j)  (256  + 64 * (j))
#define XB_XSUB(j)  (1280 + 64 * (j))
#define XB_XGEN(j)  (2304 + 64 * (j))
#define XB_TOP      3328
#define XB_TOPGEN   3392
#define XCD_BAR_WORDS 3456
#define XB_SPIN_CAP (1u << 18)
#define LAS __attribute__((address_space(3)))

__device__ __forceinline__ unsigned xb_ld(unsigned* p)              { return __hip_atomic_load(p, __ATOMIC_RELAXED, __HIP_MEMORY_SCOPE_AGENT); }
__device__ __forceinline__ unsigned xb_add(unsigned* p, unsigned v) { return __hip_atomic_fetch_add(p, v, __ATOMIC_RELAXED, __HIP_MEMORY_SCOPE_AGENT); }
__device__ __forceinline__ unsigned xb_xcc_id() { return (unsigned)__builtin_amdgcn_s_getreg((3 << 11) | 20) & 0xFu; }
#define XB_SPIN(cond, bar) do { unsigned _sp = 0; while (cond) { __builtin_amdgcn_s_sleep(1); \
    if ((++_sp & 255u) == 0u) { if (xb_ld(&(bar)[XB_TMO])) break; if (_sp > XB_SPIN_CAP) { atomicAdd(&(bar)[XB_TMO], 1u); break; } } } } while (0)

struct XcdBarrier {
    unsigned* bar; unsigned x;
    volatile LAS unsigned* st;
};

__device__ __forceinline__ XcdBarrier xcd_barrier_post(unsigned* bar, volatile LAS unsigned* st) {
    XcdBarrier b; b.bar = bar; b.x = xb_xcc_id(); b.st = st;
    if (threadIdx.x == 0) (void)xb_add(&bar[XB_XCNT(b.x)], 1u);
    return b;
}
__device__ __forceinline__ void xcd_barrier_complete(unsigned* bar, unsigned x, unsigned& nloc, unsigned& nx) {
    const unsigned G = gridDim.x * gridDim.y * gridDim.z;
    unsigned sum, cnt, mine, sp = 0u;
    for (;;) {
        sum = 0u; cnt = 0u; mine = 0u;
#pragma unroll
        for (unsigned j = 0; j < 16; ++j) { const unsigned c = xb_ld(&bar[XB_XCNT(j)]); sum += c; cnt += (c > 0u) ? 1u : 0u; mine = (j == x) ? c : mine; }
        if (sum == G) break;
        __builtin_amdgcn_s_sleep(1);
        if ((++sp & 255u) == 0u) { if (xb_ld(&bar[XB_TMO])) break; if (sp > XB_SPIN_CAP) { atomicAdd(&bar[XB_TMO], 1u); break; } }
    }
    nloc = mine > 0u ? mine : 1u; nx = cnt > 0u ? cnt : 1u;
}

__device__ __forceinline__ void xcd_barrier(const XcdBarrier& b) {
    asm volatile("s_waitcnt vmcnt(0)" ::: "memory");
    __syncthreads();
    if (threadIdx.x == 0) {
        unsigned* bar = b.bar;
        __builtin_amdgcn_s_waitcnt(0);
        unsigned nloc = b.st[0], nx = b.st[1];
        if (nloc == 0u) { xcd_barrier_complete(bar, b.x, nloc, nx); b.st[0] = nloc; b.st[1] = nx; }
        const unsigned old = xb_add(&bar[XB_XSUB(b.x)], 1u);
        const unsigned gen = old / nloc;
        if (old + 1u == (gen + 1u) * nloc) {
            __builtin_amdgcn_fence(__ATOMIC_RELEASE, "agent");
            asm volatile("s_waitcnt vmcnt(0)" ::: "memory");
            const unsigned og = xb_add(&bar[XB_TOP], 1u);
            const unsigned tg = og / nx;
            if (og + 1u == (tg + 1u) * nx) xb_add(&bar[XB_TOPGEN], 1u);
            else XB_SPIN(xb_ld(&bar[XB_TOPGEN]) == tg, bar);
            __builtin_amdgcn_fence(__ATOMIC_ACQUIRE, "agent");
            xb_add(&bar[XB_XGEN(b.x)], 1u);
            asm volatile("s_waitcnt vmcnt(0)" ::: "memory");
        } else {
            XB_SPIN(xb_ld(&bar[XB_XGEN(b.x)]) == gen, bar);
            __builtin_amdgcn_fence(__ATOMIC_ACQUIRE, "agent");
            asm volatile("s_waitcnt vmcnt(0)" ::: "memory");
        }
    }
    __syncthreads();
}


#define SMEM_BYTES (4 * (128 * BU_STR * 4 + 16 * H_STR * 4))
#define PH_PER_LAYER 11
#define N_PHASES (2 + DEPTH * PH_PER_LAYER)

__device__ __forceinline__ void run_phase(KP p, int ph, char* smem) {
  if (ph == 0) { prologue0(p, smem); return; }
  if (ph == 1) { prologue1(p); return; }
  const int layer = (ph - 2) / PH_PER_LAYER, s = (ph - 2) % PH_PER_LAYER;
  switch (s) {
    case 0: phase_inproj(p, layer, smem); break;
    case 1: phase_mix(p, layer, smem); break;
    case 2: phase_s5_combine(p, layer); gates_job(p, layer, smem); break;
    case 3: phase_fft2_glu(p, layer, smem); break;
    case 4: phase_branch(p, layer, smem); break;
    case 5: phase_outproj(p, layer, smem); break;
    case 6: phase_ln1(p, layer); break;
    case 7: phase_wq(p, layer, smem); break;
    case 8: phase_scores(p, layer, smem); break;
    case 9: phase_topk(p, layer); break;
    default: phase_peer(p, layer); break;
  }
}

__global__ void __launch_bounds__(256, 2) mega_kernel(Params p) {
  __shared__ __attribute__((aligned(16))) char smem[SMEM_BYTES];
  __shared__ uint4 xb_words;
  cg::grid_group grid = cg::this_grid();
  if (threadIdx.x == 0) xb_words = make_uint4(0u, 0u, 0u, 0u);
  __syncthreads();
  XcdBarrier xb = xcd_barrier_post(p.bar, (volatile LAS unsigned*)&xb_words);
  grid.sync();
  for (int ph = 0; ph < N_PHASES; ++ph) {
    int reps = 1;
#ifdef PROBE_REPEAT
    if (ph >= 2 && ((PROBE_REPEAT >> ((ph - 2) % PH_PER_LAYER)) & 1)) reps = 2;
    if (ph == 0 && (PROBE_REPEAT & 0x10000)) reps = 2;
#endif
    for (int r = 0; r < reps; ++r) {
      KParams* pp = (KParams*)__builtin_amdgcn_kernarg_segment_ptr();
      asm volatile("" : "+s"(pp));
      run_phase(*pp, ph, smem);
      if (ph + 1 < N_PHASES) xcd_barrier(xb);
#ifdef PROBE_SYNCS
      if (ph >= 2 && ph + 1 < N_PHASES) { xcd_barrier(xb); xcd_barrier(xb); }
#endif
    }
  }
}

#if MULTI_LAUNCH
__global__ void __launch_bounds__(256, 2) phase_kernel(Params p, int ph) {
  __shared__ __attribute__((aligned(16))) char smem[SMEM_BYTES];
  run_phase(p, ph, smem);
}

__global__ void dump_kernel(Params p, int which) {
  size_t n = (size_t)T_ALL * 1024;
  for (size_t i = (size_t)blockIdx.x * 256 + threadIdx.x; i < n; i += (size_t)gridDim.x * 256) {
    float v = 0.f;
    if (which == 0) v = i < (size_t)T_ALL * 512 ? bf_lo((u32)p.Y4[i]) : 0.f;
    else if (which == 9) v = i < (size_t)T_ALL * 512 ? bf_lo((u32)p.Y4[(size_t)T_ALL * 512 + i]) : 0.f;
    else if (which == 10) v = bf_lo((u32)p.TTt[i]);
    else if (which == 1) v = bf_lo((u32)p.Y4[(size_t)2 * T_ALL * 512 + i]);
    else if (which == 2) v = bf_lo((u32)p.MERGED[i]);
    else if (which == 3) v = p.R1[i];
    else if (which == 4) v = p.X1[i];
    else if (which == 5) v = bf_lo((u32)p.PQ[i]);
    else if (which == 6) v = p.SC[i];
    else if (which == 7) v = i < (size_t)T_ALL * 128 ? (float)p.PIDX[i] : (i < (size_t)T_ALL * 256 ? p.PG[i - (size_t)T_ALL * 128] : 0.f);
    else v = p.X[i];
    p.out[i] = v;
  }
}

#endif

extern "C" void kernel_launch(void* const* d_in, const int* in_sizes, int n_in, void* d_out, int out_size, void* d_ws,
                              size_t ws_size, hipStream_t stream) {
  Params p{};
  const float** ins = (const float**)&p;
  for (int i = 0; i < 32; ++i) ins[i] = (const float*)d_in[i];
  p.out = (float*)d_out;
  char* w = (char*)d_ws;
  size_t off = 0;
  auto take = [&](size_t bytes) { char* r = w + off; off += (bytes + 255) & ~(size_t)255; return r; };
  p.U16 = (u16*)take((size_t)DEPTH * 16384 * 1024);
  p.V16 = (u16*)take((size_t)DEPTH * 16384 * 1024);
  p.bar = (unsigned*)take((size_t)XCD_BAR_WORDS * 4);
  p.U8 = (unsigned char*)p.U16;
  p.V8 = (unsigned char*)p.V16;
  p.XM8 = (unsigned char*)take((size_t)T_ALL * 1024);
  p.WgT8 = (unsigned char*)take((size_t)DEPTH * 4096 * 1024);
  p.SCU = (float*)take((size_t)DEPTH * 16384 * 4);
  p.SCV = (float*)take((size_t)DEPTH * 16384 * 4);
  p.WinT = (u16*)take((size_t)DEPTH * NCOL * 1024 * 2);
  p.WbrT = (u16*)take((size_t)DEPTH * 4 * 1024 * 512 * 2);
  p.WoutT = (u16*)take((size_t)DEPTH * 1024 * 1024 * 2);
  p.WqT = (u16*)take((size_t)DEPTH * 2048 * 1024 * 2);
  p.WgluT = (u16*)take((size_t)DEPTH * 512 * 512 * 2);
  p.SK16 = (u16*)take((size_t)DEPTH * 16 * 128 * 128 * 2);
  p.FC = (u16*)take((size_t)256 * 128 * 2);
  p.FL256 = (u16*)take((size_t)256 * 512 * 2);
  p.FL1024 = (u16*)take((size_t)1024 * 2048 * 2);
  p.CK16 = (u16*)take((size_t)16 * 256 * 128 * 2);
  p.CVT16 = (u16*)take((size_t)16 * 256 * 128 * 2);
  p.MOD = (float*)take((size_t)DEPTH * 5 * 6144 * 4);
  p.ROPE = (float*)take((size_t)2048 * 4);
  p.X = (float*)take((size_t)T_ALL * 1024 * 4);
  p.X1 = (float*)take((size_t)T_ALL * 1024 * 4);
  p.XM = (u16*)take((size_t)T_ALL * 1024 * 2);
  p.XM2 = (u16*)take((size_t)T_ALL * 1024 * 2);
  p.PIDX = (int*)take((size_t)T_ALL * 128 * 4);
  p.PG = (float*)take((size_t)T_ALL * 128 * 4);
  p.ZF = (u16*)take((size_t)T_ALL * 512 * 2);
  p.ZCV = (u16*)take((size_t)T_ALL * 1536 * 2);
  p.ZS = (float*)take((size_t)T_ALL * 512 * 4);
  p.Q16 = (u16*)take((size_t)T_ALL * 512 * 2);
  p.K16 = (u16*)take((size_t)T_ALL * 128 * 2);
  p.VT = (u16*)take((size_t)T_ALL * 128 * 2);
  p.TTt = (u16*)take((size_t)T_ALL * 4 * 256 * 2);
  p.Y4 = (u16*)take((size_t)4 * T_ALL * 512 * 2);
  p.YS = (u16*)take((size_t)T_ALL * 512 * 2);
  p.YBK = (float*)take((size_t)T_ALL * 512 * 4);
  p.MERGED = (u16*)take((size_t)T_ALL * 1024 * 2);
  p.G = (u16*)take((size_t)T_ALL * 4096 * 2);
  p.R1 = (float*)p.G;
  p.PQ = (u16*)((char*)p.G + (size_t)T_ALL * 1024 * 4);
  p.SC = (float*)p.ZF;
  if (off > ws_size) { fprintf(stderr, "workspace too small: need %zu have %zu\n", off, ws_size); return; }
#if MULTI_LAUNCH
#ifndef DEBUG_NPH
#define DEBUG_NPH N_PHASES
#endif
  for (int ph = 0; ph < DEBUG_NPH; ++ph) phase_kernel<<<dim3(1024), dim3(256), 0, stream>>>(p, ph);
#ifdef DEBUG_DUMP
  dump_kernel<<<dim3(1024), dim3(256), 0, stream>>>(p, DEBUG_DUMP);
#endif
#else
  static int grid_blocks = 0;
  if (!grid_blocks) {
    int dev = 0, cus = 0, per_cu = 0;
    hipGetDevice(&dev);
    hipDeviceGetAttribute(&cus, hipDeviceAttributeMultiprocessorCount, dev);
    hipOccupancyMaxActiveBlocksPerMultiprocessor(&per_cu, mega_kernel, 256, 0);
    if (per_cu > 2) per_cu = 2;
    grid_blocks = cus * per_cu;
  }
  hipMemsetAsync(p.bar, 0, (size_t)XCD_BAR_WORDS * 4, stream);
  void* args[] = {&p};
  hipError_t e = hipLaunchCooperativeKernel((void*)mega_kernel, dim3(grid_blocks), dim3(256), args, 0, stream);
  if (e != hipSuccess) fprintf(stderr, "cooperative launch failed: %s (grid %d)\n", hipGetErrorString(e), grid_blocks);
#endif
}
```
